# Optimizing an MI355X kernel written in HIP

```python
import jax
import jax.numpy as jnp
from jax import lax
import numpy as np

D_MODEL = 1024
BATCH = 8
SEQ = 4096
DEPTH = 4

CHUNK = 64
N_EVEN = (DEPTH + 1) // 2
N_ODD = DEPTH // 2
PLE_DIM = 256
D_FF = ((-(-8 * D_MODEL // 3) + 255) // 256) * 256
GROUP_WIDTH = D_MODEL // 2
RMS_EPS = 1e-6
L2_EPS = 1e-6
GN_EPS = 64e-5

RG_WIDTH = GROUP_WIDTH
RG_BLOCKS = 8
RG_BLOCK = RG_WIDTH // RG_BLOCKS
RG_CONV = 4
RG_C = 8.0

GDN_DK = 128
GDN_DV = 128
GDN_HEADS = GROUP_WIDTH // GDN_DV
GDN_WIDTH = GDN_HEADS * GDN_DV
GDN_CONV = 4

HG_DK = 128
HG_DV = 128
HG_HEADS = GROUP_WIDTH // HG_DV
HG_WIDTH = HG_HEADS * HG_DV

R7_N = 64
R7_HEADS = GROUP_WIDTH // R7_N
R7_WIDTH = R7_HEADS * R7_N
R7_DECAY_LORA = 64
R7_AAA_LORA = 64
R7_GATE_LORA = 128

EVEN_SIZES = (RG_WIDTH, RG_WIDTH, GDN_HEADS * GDN_DK, GDN_HEADS * GDN_DK, GDN_WIDTH, GDN_WIDTH, GDN_HEADS, GDN_HEADS)
GDN_QKV_SIZES = (GDN_HEADS * GDN_DK, GDN_HEADS * GDN_DK, GDN_WIDTH)
HG_SIZES = (HG_HEADS * HG_DK, HG_HEADS * HG_DK, HG_WIDTH, HG_WIDTH)
R7_SIZES = (R7_WIDTH, R7_WIDTH, R7_WIDTH, R7_DECAY_LORA, R7_AAA_LORA, R7_GATE_LORA)
EVEN_IN = sum(EVEN_SIZES)
HG_IN = sum(HG_SIZES)
R7_IN = sum(R7_SIZES)
ODD_IN = HG_IN + R7_IN
MIX_OUT = 2 * GROUP_WIDTH

kernel_name = "hybrid_rglru_gdn_hgrn2_rwkv7_trunk"


def _rms_norm(x, w):
    xf = x.astype(jnp.float32)
    y = xf * lax.rsqrt(jnp.mean(xf * xf, axis=-1, keepdims=True) + RMS_EPS)
    return (y * w.astype(jnp.float32)).astype(x.dtype)


def _l2norm(x):
    return x * lax.rsqrt(jnp.sum(x * x, axis=-1, keepdims=True) + L2_EPS)


def _split(z, sizes):
    return jnp.split(z, np.cumsum(sizes)[:-1].tolist(), axis=-1)


def _causal_dwconv(x, w):
    k_width, ch = w.shape
    return lax.conv_general_dilated(
        x, w.astype(x.dtype)[:, None, :], window_strides=(1,), padding=[(k_width - 1, 0)],
        dimension_numbers=("NWC", "WIO", "NWC"), feature_group_count=ch)


def _token_shift(x):
    return jnp.pad(x[:, :-1], ((0, 0), (1, 0), (0, 0)))


def _to_chunks(t):
    b, s = t.shape[:2]
    t = t.reshape(b, s // CHUNK, CHUNK, *t.shape[2:])
    return jnp.transpose(t, (1, 0, 3, 2) + tuple(range(4, t.ndim)))


def _from_chunks(t):
    t = jnp.transpose(t, (1, 0, 3, 2) + tuple(range(4, t.ndim)))
    return t.reshape(t.shape[0], t.shape[1] * t.shape[2], *t.shape[3:])


def _rg_lru(x, w_r, b_r, w_i, b_i, lam):
    bn, s, _ = x.shape
    xb = x.reshape(bn, s, RG_BLOCKS, RG_BLOCK)
    r = jax.nn.sigmoid(jnp.einsum("bsgi,gij->bsgj", xb, w_r).reshape(bn, s, RG_WIDTH) + b_r)
    i = jax.nn.sigmoid(jnp.einsum("bsgi,gij->bsgj", xb, w_i).reshape(bn, s, RG_WIDTH) + b_i)
    log_a = -RG_C * r * jax.nn.softplus(-lam)
    mult = jnp.sqrt(-jnp.expm1(2.0 * log_a))
    mult = jnp.where((jnp.arange(s) == 0)[None, :, None], 1.0, mult)
    u = mult * (i * x)

    def combine(left, right):
        a_l, h_l = left
        a_r, h_r = right
        return a_l * a_r, a_r * h_l + h_r

    _, h = lax.associative_scan(combine, (jnp.exp(log_a), u), axis=1)
    return h


def _gated_delta_rule(q, k, v, g, beta):
    bn, s, h, dk = q.shape
    dv = v.shape[-1]
    qc = _to_chunks(q * dk ** -0.5)
    kc, vc = _to_chunks(k), _to_chunks(v)
    gc = jnp.cumsum(_to_chunks(g), axis=-1)
    bc = _to_chunks(beta)
    causal = jnp.tril(jnp.ones((CHUNK, CHUNK), dtype=bool))
    strict = jnp.tril(jnp.ones((CHUNK, CHUNK), dtype=bool), -1)
    decay = jnp.exp(jnp.where(causal, gc[..., :, None] - gc[..., None, :], -jnp.inf))
    kb = kc * bc[..., None]
    a_mat = jnp.where(strict, jnp.einsum("nbhcd,nbhsd->nbhcs", kb, kc) * decay, 0.0)
    rhs = jnp.concatenate([vc * bc[..., None], kb * jnp.exp(gc)[..., None]], axis=-1)
    sol = lax.linalg.triangular_solve(a_mat + jnp.eye(CHUNK, dtype=a_mat.dtype), rhs,
                                      left_side=True, lower=True, unit_diagonal=True)
    u, w = sol[..., :dv], sol[..., dv:]
    qk = jnp.einsum("nbhcd,nbhsd->nbhcs", qc, kc) * decay
    q_dec = qc * jnp.exp(gc)[..., None]
    g_last = gc[..., -1]
    k_dec = kc * jnp.exp(g_last[..., None] - gc)[..., None]

    def step(state, xs):
        u_c, w_c, qk_c, qd_c, kd_c, gl_c = xs
        v_new = u_c - jnp.einsum("bhcd,bhde->bhce", w_c, state)
        o = jnp.einsum("bhcd,bhde->bhce", qd_c, state) + jnp.einsum("bhcs,bhse->bhce", qk_c, v_new)
        state = jnp.exp(gl_c)[..., None, None] * state + jnp.einsum("bhcd,bhce->bhde", kd_c, v_new)
        return state, o

    _, o = lax.scan(step, jnp.zeros((bn, h, dk, dv), jnp.float32), (u, w, qk, q_dec, k_dec, g_last))
    return _from_chunks(o)


def _hgrn2_chunked(q, k, v, log_f):
    bn, s, h, dk = q.shape
    dv = v.shape[-1]
    causal = jnp.tril(jnp.ones((CHUNK, CHUNK), dtype=bool))
    bc = jnp.cumsum(_to_chunks(log_f), axis=3)

    def step(state, xs):
        q_c, k_c, v_c, b_c = xs
        rel = jnp.exp(jnp.where(causal[:, :, None], b_c[:, :, :, None, :] - b_c[:, :, None, :, :], -jnp.inf))
        scores = jnp.einsum("bhtd,bhsd,bhtsd->bhts", q_c, k_c, rel)
        b_last = b_c[:, :, -1]
        o = (jnp.einsum("bhts,bhse->bhte", scores, v_c)
             + jnp.einsum("bhtd,bhde->bhte", q_c * jnp.exp(b_c), state))
        state = (jnp.exp(b_last)[..., None] * state
                 + jnp.einsum("bhsd,bhse->bhde", k_c * jnp.exp(b_last[:, :, None] - b_c), v_c))
        return state, o

    xs = (_to_chunks(q), _to_chunks(k), _to_chunks(v), bc)
    _, o = lax.scan(step, jnp.zeros((bn, h, dk, dv), jnp.float32), xs)
    return _from_chunks(o)


def _rwkv7_scan(r, w, k, v, kk, a):
    bn, s, h, n = r.shape

    def step(state, xs):
        r_t, w_t, k_t, v_t, kk_t, a_t = xs
        sa = jnp.einsum("bhij,bhj->bhi", state, -kk_t)
        state = (state * w_t[:, :, None, :] + sa[..., None] * (kk_t * a_t)[:, :, None, :]
                 + v_t[..., None] * k_t[:, :, None, :])
        return state, jnp.einsum("bhij,bhj->bhi", state, r_t)

    xs = tuple(jnp.moveaxis(t, 1, 0) for t in (r, w, k, v, kk, a))
    _, y = lax.scan(step, jnp.zeros((bn, h, n, n), jnp.float32), xs)
    return jnp.moveaxis(y, 0, 1)


def _even_mixer(h, w_in, rg_conv_w, rg_conv_b, rg_w_r, rg_b_r, rg_w_i, rg_b_i, rg_lambda,
                gdn_conv_w, gdn_a_log, gdn_dt_bias, gdn_norm_w, w_out):
    bn, s, _ = h.shape
    z = (h @ w_in).astype(jnp.float32)
    xa, ya, q, k, v, zg, a_in, b_in = _split(z, EVEN_SIZES)
    xa = _causal_dwconv(xa, rg_conv_w) + rg_conv_b
    out_a = _rg_lru(xa, rg_w_r, rg_b_r, rg_w_i, rg_b_i, rg_lambda) * jax.nn.gelu(ya)
    qkv = jax.nn.silu(_causal_dwconv(jnp.concatenate([q, k, v], axis=-1), gdn_conv_w))
    q, k, v = _split(qkv, GDN_QKV_SIZES)
    q = _l2norm(q.reshape(bn, s, GDN_HEADS, GDN_DK))
    k = _l2norm(k.reshape(bn, s, GDN_HEADS, GDN_DK))
    v = v.reshape(bn, s, GDN_HEADS, GDN_DV)
    beta = jax.nn.sigmoid(b_in)
    g = -jnp.exp(gdn_a_log) * jax.nn.softplus(a_in + gdn_dt_bias)
    o = _gated_delta_rule(q, k, v, g, beta)
    o = _rms_norm(o, gdn_norm_w) * jax.nn.silu(zg.reshape(bn, s, GDN_HEADS, GDN_DV))
    out_b = o.reshape(bn, s, GDN_WIDTH)
    mixed = jnp.concatenate([out_a, out_b], axis=-1).astype(h.dtype)
    return mixed @ w_out


def _odd_mixer(h, w_in, lower_bound, hg_norm_w, r7_mu, r7_w0, r7_w2, r7_a0, r7_a2, r7_g2,
               r7_k_k, r7_k_a, r7_r_k, r7_ln_w, r7_ln_b, w_out):
    bn, s, _ = h.shape
    z = (h @ w_in).astype(jnp.float32)
    zc, zd = z[..., :HG_IN], z[..., HG_IN:]

    def heads(t, d):
        return t.reshape(bn, s, -1, d)

    q, f, i, g = _split(zc, HG_SIZES)
    lb = jnp.maximum(lower_bound.astype(jnp.float32), 0.0)
    key_in = (1.0 - lb) * jax.nn.sigmoid(-f)
    log_f = jnp.logaddexp(jnp.log(lb), jnp.log1p(-lb) + jax.nn.log_sigmoid(f))
    o = _hgrn2_chunked(heads(jax.nn.silu(q), HG_DK), heads(key_in, HG_DK), heads(i, HG_DV), heads(log_f, HG_DK))
    out_c = _rms_norm(o.reshape(bn, s, HG_WIDTH), hg_norm_w) * jax.nn.sigmoid(g)
    zd = zd + r7_mu * (_token_shift(zd) - zd)
    r, k, v, w_l, a_l, g_l = _split(zd, R7_SIZES)
    w = jnp.exp(-jnp.exp(-jax.nn.softplus(-(r7_w0 + jnp.tanh(w_l) @ r7_w2)) - 0.5))
    a = jax.nn.sigmoid(r7_a0 + a_l @ r7_a2)
    gate = jax.nn.sigmoid(g_l) @ r7_g2
    kk = _l2norm(heads(k * r7_k_k, R7_N))
    k = k * (1.0 + (a - 1.0) * r7_k_a)
    r_h, k_h, v_h = heads(r, R7_N), heads(k, R7_N), heads(v, R7_N)
    y = _rwkv7_scan(r_h, heads(w, R7_N), k_h, v_h, kk, heads(a, R7_N))
    mean = jnp.mean(y, axis=-1, keepdims=True)
    var = jnp.mean(jnp.square(y - mean), axis=-1, keepdims=True)
    y = ((y - mean) * lax.rsqrt(var + GN_EPS)).reshape(bn, s, R7_WIDTH) * r7_ln_w + r7_ln_b
    bonus = jnp.sum(r_h * k_h * r7_r_k, axis=-1, keepdims=True) * v_h
    out_d = (y + bonus.reshape(bn, s, R7_WIDTH)) * gate
    mixed = jnp.concatenate([out_c, out_d], axis=-1).astype(h.dtype)
    return mixed @ w_out


def _swiglu(h, w_gate, w_up, w_down):
    return (jax.nn.silu(h @ w_gate) * (h @ w_up)) @ w_down


def setup_inputs(seed: int = 0) -> dict:
    key = jax.random.key(seed)
    keys = jax.random.split(key, 64)
    counter = [0]

    def nk():
        counter[0] += 1
        return keys[counter[0] - 1]

    def nrm(shape, scale):
        return jax.random.normal(nk(), shape, jnp.float32) * scale

    def unif(shape, lo, hi):
        return jax.random.uniform(nk(), shape, jnp.float32, lo, hi)

    def gain(shape):
        return 1.0 + nrm(shape, 0.01)

    a_rg = unif((N_EVEN, RG_WIDTH), 0.9, 0.999) ** (1.0 / RG_C)
    dt = jnp.exp(unif((N_EVEN, GDN_HEADS), float(np.log(1e-3)), float(np.log(1e-1))))
    return {
        "x": nrm((BATCH, SEQ, D_MODEL), 1.0),
        "p": nrm((DEPTH, BATCH, SEQ, PLE_DIM), 1.0),
        "norm_mix": gain((DEPTH, D_MODEL)),
        "norm_ffn": gain((DEPTH, D_MODEL)),
        "norm_ple": gain((DEPTH, D_MODEL)),
        "norm_final": gain((D_MODEL,)),
        "e_w_in": nrm((N_EVEN, D_MODEL, EVEN_IN), D_MODEL ** -0.5),
        "rg_conv_w": nrm((N_EVEN, RG_CONV, RG_WIDTH), RG_CONV ** -0.5),
        "rg_conv_b": nrm((N_EVEN, RG_WIDTH), 0.01),
        "rg_w_r": nrm((N_EVEN, RG_BLOCKS, RG_BLOCK, RG_BLOCK), RG_BLOCK ** -0.5),
        "rg_b_r": nrm((N_EVEN, RG_WIDTH), 0.01),
        "rg_w_i": nrm((N_EVEN, RG_BLOCKS, RG_BLOCK, RG_BLOCK), RG_BLOCK ** -0.5),
        "rg_b_i": nrm((N_EVEN, RG_WIDTH), 0.01),
        "rg_lambda": jnp.log(a_rg) - jnp.log1p(-a_rg),
        "gdn_conv_w": nrm((N_EVEN, GDN_CONV, sum(GDN_QKV_SIZES)), GDN_CONV ** -0.5),
        "gdn_a_log": jnp.log(unif((N_EVEN, GDN_HEADS), 1.0, 16.0)),
        "gdn_dt_bias": dt + jnp.log(-jnp.expm1(-dt)),
        "gdn_norm_w": gain((N_EVEN, GDN_DV)),
        "e_w_out": nrm((N_EVEN, MIX_OUT, D_MODEL), MIX_OUT ** -0.5),
        "o_w_in": nrm((N_ODD, D_MODEL, ODD_IN), D_MODEL ** -0.5),
        "hg_lower_bounds": nrm((N_ODD, HG_HEADS * HG_DK), 0.1),
        "hg_norm_w": gain((N_ODD, HG_WIDTH)),
        "r7_mu": unif((N_ODD, R7_IN), 0.0, 1.0),
        "r7_w0": unif((N_ODD, R7_WIDTH), -6.0, 0.0),
        "r7_w2": nrm((N_ODD, R7_DECAY_LORA, R7_WIDTH), 0.5 * R7_DECAY_LORA ** -0.5),
        "r7_a0": nrm((N_ODD, R7_WIDTH), 0.1),
        "r7_a2": nrm((N_ODD, R7_AAA_LORA, R7_WIDTH), 0.5 * R7_AAA_LORA ** -0.5),
        "r7_g2": nrm((N_ODD, R7_GATE_LORA, R7_WIDTH), R7_GATE_LORA ** -0.5),
        "r7_k_k": 0.85 + nrm((N_ODD, R7_WIDTH), 0.01),
        "r7_k_a": gain((N_ODD, R7_WIDTH)),
        "r7_r_k": nrm((N_ODD, R7_HEADS, R7_N), 0.1),
        "r7_ln_w": gain((N_ODD, R7_WIDTH)),
        "r7_ln_b": nrm((N_ODD, R7_WIDTH), 0.01),
        "o_w_out": nrm((N_ODD, MIX_OUT, D_MODEL), MIX_OUT ** -0.5),
        "ffn_w_gate": nrm((DEPTH, D_MODEL, D_FF), D_MODEL ** -0.5),
        "ffn_w_up": nrm((DEPTH, D_MODEL, D_FF), D_MODEL ** -0.5),
        "ffn_w_down": nrm((DEPTH, D_FF, D_MODEL), D_FF ** -0.5),
        "ple_w_up": nrm((DEPTH, PLE_DIM, D_MODEL), PLE_DIM ** -0.5),
        "ple_w_gate": nrm((DEPTH, D_MODEL, D_MODEL), D_MODEL ** -0.5),
    }


def reference(x, p, norm_mix, norm_ffn, norm_ple, norm_final,
              e_w_in, rg_conv_w, rg_conv_b, rg_w_r, rg_b_r, rg_w_i, rg_b_i, rg_lambda,
              gdn_conv_w, gdn_a_log, gdn_dt_bias, gdn_norm_w, e_w_out,
              o_w_in, hg_lower_bounds, hg_norm_w, r7_mu, r7_w0, r7_w2, r7_a0, r7_a2, r7_g2,
              r7_k_k, r7_k_a, r7_r_k, r7_ln_w, r7_ln_b, o_w_out,
              ffn_w_gate, ffn_w_up, ffn_w_down, ple_w_up, ple_w_gate):
    lb_soft = jax.nn.softmax(hg_lower_bounds.astype(jnp.float32), axis=0)
    hg_lb = jnp.cumsum(lb_soft, axis=0) - lb_soft[0]
    h = x
    for layer in range(DEPTH):
        j = layer // 2
        hn = _rms_norm(h, norm_mix[layer])
        if layer % 2 == 0:
            h = h + _even_mixer(hn, e_w_in[j], rg_conv_w[j], rg_conv_b[j], rg_w_r[j], rg_b_r[j],
                                rg_w_i[j], rg_b_i[j], rg_lambda[j], gdn_conv_w[j], gdn_a_log[j],
                                gdn_dt_bias[j], gdn_norm_w[j], e_w_out[j])
        else:
            h = h + _odd_mixer(hn, o_w_in[j], hg_lb[j], hg_norm_w[j], r7_mu[j], r7_w0[j], r7_w2[j],
                               r7_a0[j], r7_a2[j], r7_g2[j], r7_k_k[j], r7_k_a[j], r7_r_k[j],
                               r7_ln_w[j], r7_ln_b[j], o_w_out[j])
        h = h + _swiglu(_rms_norm(h, norm_ffn[layer]), ffn_w_gate[layer], ffn_w_up[layer], ffn_w_down[layer])
        ple_gate = jax.nn.sigmoid(_rms_norm(h, norm_ple[layer]) @ ple_w_gate[layer])
        h = h + ple_gate * (p[layer] @ ple_w_up[layer])
    return _rms_norm(h, norm_final)
```

```cpp
#include <hip/hip_runtime.h>
#include <hip/hip_cooperative_groups.h>
#include <cstdio>
#include <cstdint>
namespace cg = cooperative_groups;
namespace pg8 {
#define PG8_LAS __attribute__((address_space(3)))
typedef unsigned short bf16_t;
typedef short bf16x8 __attribute__((ext_vector_type(8)));
typedef float f32x4 __attribute__((ext_vector_type(4)));
typedef unsigned u32x4 __attribute__((ext_vector_type(4)));
constexpr int BM = 256, BK = 64, HALF = 128, HTB = HALF * BK * 2  , STAGE_BYTES = 8 * HTB, NXCD = 8, WGM = 8;

__host__ __device__ __forceinline__ int lds_byte(int r, int c) { const int st = (r >> 4) * 2 + (c >> 5), rr = r & 15, cc = c & 31, ob = rr * 64 + cc * 2; return st * 1024 + (ob ^ (((ob >> 9) & 1) << 5)); }
__host__ __device__ __forceinline__ void stage_rc(int b, int& R, int& C) { const int st = b / 1024, sb = b % 1024, swz = sb ^ (((sb >> 9) & 1) << 5); R = (st >> 1) * 16 + swz / 64; C = (st & 1) * 32 + (swz % 64) / 2; }
__host__ __device__ __forceinline__ int perm32(int rho) { const int n = rho >> 4, i = rho & 15; return 8 * (i >> 2) + 4 * n + (i & 3); }

struct Unit { int pm, pn; };
struct Gemm { const bf16_t* A; const bf16_t* Bt; int M, N, K; };

struct StaticOrder {
    int nM, nN, nwg, G, c;
    __host__ __device__ void init(int M, int N, int G_, int c_) { nM = M / BM; nN = N / BM; nwg = nM * nN; G = G_; c = c_; }
    __host__ __device__ bool next(int i, Unit& u) const {
        const long L = (long)i * G + c; if (L >= nwg) return false;
        int wgid = (int)L; { const int q = nwg / NXCD, r = nwg % NXCD, xcd = wgid % NXCD, off = wgid / NXCD; wgid = (xcd < r ? xcd * (q + 1) : r * (q + 1) + (xcd - r) * q) + off; }
        const int nig = WGM * nN, gid = wgid / nig, fm = gid * WGM, gsz = (nM - fm) < WGM ? (nM - fm) : WGM;
        u.pm = fm + ((wgid % nig) % gsz); u.pn = (wgid % nig) / gsz; return true;
    }
    __device__ __forceinline__ void a_ready(const Unit&) const {}
    __device__ __forceinline__ void done(const Unit&) const {}
};
}
namespace pg8 {
__device__ __forceinline__ unsigned cvt_pk_bf16(float lo, float hi) { unsigned r; asm volatile("v_cvt_pk_bf16_f32 %0, %1, %2" : "=v"(r) : "v"(lo), "v"(hi)); return r; }
typedef float f32x2 __attribute__((ext_vector_type(2)));
template <class Epi, class Sched, bool STAMP = false>
__device__ __forceinline__ void gemm_phase(PG8_LAS unsigned char* lds, const Gemm g, const Sched& S, const Epi& E, unsigned long long* stamps) {
    int tid_l = threadIdx.x; asm volatile("" : "+v"(tid_l));
    const int tid = tid_l, wid = __builtin_amdgcn_readfirstlane(tid >> 6), lane = tid & 63, wr = wid >> 2, wc = wid & 3, fr = lane & 15, fq = lane >> 4;
    const int K = g.K, nt = K / BK;
    int ts_lo = 0, ts_hi = 0, nts = 0; const unsigned long long rt_entry = STAMP ? (unsigned long long)wall_clock64() : 0ull;
#define PG8_STAMP() do { if (STAMP && wid == 0 && nts < 64) { const unsigned long long _c = (unsigned long long)clock64(); \
        ts_lo = (lane == nts) ? (int)(unsigned)_c : ts_lo; ts_hi = (lane == nts) ? (int)(unsigned)(_c >> 32) : ts_hi; ++nts; } } while (0)
    PG8_STAMP();
    unsigned voffA[2], voffB[2];
#pragma unroll
    for (int i = 0; i < 2; ++i) { int R, C; stage_rc(tid * 16 + i * 8192, R, C); const int Rb = Epi::PERM ? ((R & ~31) + perm32(R & 31)) : R;
        voffA[i] = (unsigned)(R * K + C) * 2u; voffB[i] = (unsigned)(Rb * K + C) * 2u; }
    const size_t kstep = (size_t)(BK * 2);
    const size_t hstep = (size_t)HALF * K * 2;
    const size_t tstep = 2 * hstep;
    const unsigned ldsw = (unsigned)wid * 1024u;
    const int aoff = lds_byte(wr * 64 + fr, fq * 8), boff = lds_byte(wc * 32 + fr, fq * 8);
#define PG8_SA(b, h) (((b) * 2 + (h)) * HTB)
#define PG8_SB(b, h) ((4 + (b) * 2 + (h)) * HTB)
#define PG8_STAGE(bufoff, gbase, voff) do { _Pragma("unroll") for (int _i = 0; _i < 2; ++_i) \
        __builtin_amdgcn_global_load_lds((const unsigned*)((const char*)(gbase) + (voff)[_i]), (PG8_LAS unsigned*)(lds + (bufoff) + ldsw + _i * 8192), 16, 0, 0); } while (0)
#define PG8_LDA(dst, b, h) do { _Pragma("unroll") for (int m = 0; m < 4; ++m) _Pragma("unroll") for (int k = 0; k < 2; ++k) dst[m][k] = *(const PG8_LAS bf16x8*)(lds + PG8_SA(b, h) + aoff + m * 2048 + k * 1024); } while (0)
#define PG8_LDB(dst, b, h) do { _Pragma("unroll") for (int n = 0; n < 2; ++n) _Pragma("unroll") for (int k = 0; k < 2; ++k) dst[n][k] = *(const PG8_LAS bf16x8*)(lds + PG8_SB(b, h) + boff + n * 2048 + k * 1024); } while (0)
#define PG8_MMA(ai, bj, At, Bt) do { __builtin_amdgcn_s_setprio(1); _Pragma("unroll") for (int m = 0; m < 4; ++m) _Pragma("unroll") for (int n = 0; n < 2; ++n) _Pragma("unroll") for (int k = 0; k < 2; ++k) \
        acc[ai][bj][m][n] = __builtin_amdgcn_mfma_f32_16x16x32_bf16(Bt[n][k], At[m][k], acc[ai][bj][m][n], 0, 0, 0); __builtin_amdgcn_s_setprio(0); } while (0)
#define PG8_WAIT_V(n) asm volatile("s_waitcnt vmcnt(" #n ")" ::: "memory")
#define PG8_WAIT_L(n) asm volatile("s_waitcnt lgkmcnt(" #n ")" ::: "memory")
#define PG8_BAR __builtin_amdgcn_s_barrier()
#define PG8_SCHED __builtin_amdgcn_sched_barrier(0)
    Unit cur, nxt; int ui = 0;
    if (!S.next(0, cur)) return;
    f32x4 acc[2][2][4][2];
#pragma unroll
    for (int a = 0; a < 2; ++a)
#pragma unroll
        for (int b = 0; b < 2; ++b)
#pragma unroll
            for (int m = 0; m < 4; ++m)
#pragma unroll
                for (int n = 0; n < 2; ++n) acc[a][b][m][n] = (f32x4){0.f, 0.f, 0.f, 0.f};
    bf16x8 At[4][2], B0[2][2], B1[2][2];
    const char* cA = (const char*)g.A + (size_t)cur.pm * tstep; const char* cB = (const char*)g.Bt + (size_t)cur.pn * tstep;
    S.a_ready(cur);
    PG8_STAGE(PG8_SB(0, 0), cB, voffB); PG8_STAGE(PG8_SA(0, 0), cA, voffA); PG8_STAGE(PG8_SB(0, 1), cB + hstep, voffB); PG8_STAGE(PG8_SA(0, 1), cA + hstep, voffA);
    if (wr == 1) PG8_BAR;
    PG8_WAIT_V(4); PG8_BAR;
    PG8_STAGE(PG8_SB(1, 0), cB + kstep, voffB); PG8_STAGE(PG8_SA(1, 0), cA + kstep, voffA); PG8_STAGE(PG8_SB(1, 1), cB + hstep + kstep, voffB);
    PG8_WAIT_V(6); PG8_BAR;
    PG8_STAMP();
    for (;;) {
        const bool has_next = S.next(ui + 1, nxt);
        const char* nA = has_next ? (const char*)g.A + (size_t)nxt.pm * tstep : cA; const char* nB = has_next ? (const char*)g.Bt + (size_t)nxt.pn * tstep : cB;
        for (int t = 0; t < nt; t += 2) {
            const bool last = (t == nt - 2);
            const char* a1 = cA + (size_t)(t + 1) * kstep;
            const char* a2 = last ? nA : cA + (size_t)(t + 2) * kstep; const char* b2 = last ? nB : cB + (size_t)(t + 2) * kstep;
            const char* a3 = a2 + kstep; const char* b3 = b2 + kstep;
            if (last && has_next) S.a_ready(nxt);
            PG8_LDB(B0, 0, 0); PG8_SCHED; PG8_LDA(At, 0, 0); PG8_STAGE(PG8_SA(1, 1), a1 + hstep, voffA);
            PG8_WAIT_L(8); PG8_BAR; PG8_WAIT_L(0); PG8_MMA(0, 0, At, B0); PG8_BAR; PG8_SCHED;
            PG8_LDB(B1, 0, 1); PG8_STAGE(PG8_SB(0, 0), b2, voffB);
            PG8_BAR; PG8_WAIT_L(0); PG8_MMA(0, 1, At, B1); PG8_BAR;
            PG8_LDA(At, 0, 1); PG8_STAGE(PG8_SA(0, 0), a2, voffA);
            PG8_BAR; PG8_WAIT_L(0); PG8_MMA(1, 0, At, B0); PG8_BAR; PG8_SCHED;
            PG8_STAGE(PG8_SB(0, 1), b2 + hstep, voffB);
            PG8_WAIT_V(6); PG8_BAR; PG8_MMA(1, 1, At, B1); PG8_BAR;
            PG8_LDB(B0, 1, 0); PG8_SCHED; PG8_LDA(At, 1, 0); PG8_STAGE(PG8_SA(0, 1), a2 + hstep, voffA);
            PG8_WAIT_L(8); PG8_BAR; PG8_WAIT_L(0); PG8_MMA(0, 0, At, B0); PG8_BAR; PG8_SCHED;
            PG8_LDB(B1, 1, 1); PG8_STAGE(PG8_SB(1, 0), b3, voffB);
            PG8_BAR; PG8_WAIT_L(0); PG8_MMA(0, 1, At, B1); PG8_BAR;
            PG8_LDA(At, 1, 1); PG8_STAGE(PG8_SA(1, 0), a3, voffA);
            PG8_BAR; PG8_WAIT_L(0); PG8_MMA(1, 0, At, B0); PG8_BAR; PG8_SCHED;
            PG8_STAGE(PG8_SB(1, 1), b3 + hstep, voffB);
            PG8_WAIT_V(6); PG8_BAR; PG8_MMA(1, 1, At, B1); PG8_BAR;
        }
        PG8_STAMP();
        if constexpr (!Epi::AFTER_DRAIN) { E(acc, cur, wr, wc, fr, fq); S.done(cur); }
        PG8_STAMP();
        if (!has_next) break;
#pragma unroll
        for (int a = 0; a < 2; ++a)
#pragma unroll
            for (int b = 0; b < 2; ++b)
#pragma unroll
                for (int m = 0; m < 4; ++m)
#pragma unroll
                    for (int n = 0; n < 2; ++n) acc[a][b][m][n] = (f32x4){0.f, 0.f, 0.f, 0.f};
        cur = nxt; cA = nA; cB = nB; ++ui;
    }
    PG8_WAIT_V(0);
    if (wr == 0) PG8_BAR;
    PG8_BAR;
    if constexpr (Epi::AFTER_DRAIN) { E.fused(acc, cur, wr, wc, fr, fq, lds, wid, lane); S.done(cur); }
    PG8_STAMP();
    if (STAMP && wid == 0) { stamps[lane] = lane < nts ? (((unsigned long long)(unsigned)ts_hi << 32) | (unsigned)ts_lo) : 0ull;
        if (lane == 62) stamps[62] = rt_entry; if (lane == 63) stamps[63] = (unsigned long long)wall_clock64(); }
#undef PG8_STAMP
#undef PG8_SA
#undef PG8_SB
#undef PG8_STAGE
#undef PG8_LDA
#undef PG8_LDB
#undef PG8_MMA
#undef PG8_WAIT_V
#undef PG8_WAIT_L
#undef PG8_BAR
#undef PG8_SCHED
}
}

using pg8::bf16_t; using pg8::f32x4; using pg8::u32x4; using pg8::bf16x8; using pg8::Unit; using pg8::cvt_pk_bf16;
typedef unsigned u32x2 __attribute__((ext_vector_type(2)));
#define LAS __attribute__((address_space(3)))

constexpr int T = 32768, DM = 1024, FF = 2816, SEQ = 4096;
constexpr int EVN = 3328, ODN = 3840;
constexpr int LDS_BYTES = 147456;
constexpr size_t WE_IN = 0, WE_OUT = WE_IN + (size_t)3328 * 1024, WE_GU = WE_OUT + (size_t)1024 * 1024, WE_DN = WE_GU + (size_t)5632 * 1024,
                 WE_PG = WE_DN + (size_t)1024 * 2816, WE_PU = WE_PG + (size_t)1024 * 1024, WE_END = WE_PU + (size_t)1024 * 256;
constexpr size_t WO_BASE = WE_END;
constexpr size_t WO_IN = 0, WO_LORA = WO_IN + (size_t)3840 * 1024, WO_OUT = WO_LORA + (size_t)1536 * 256, WO_GU = WO_OUT + (size_t)1024 * 1024,
                 WO_DN = WO_GU + (size_t)5632 * 1024, WO_PG = WO_DN + (size_t)1024 * 2816, WO_PU = WO_PG + (size_t)1024 * 1024, WO_END = WO_PU + (size_t)1024 * 256;
constexpr size_t OFF_W = 0;
constexpr size_t OFF_Z = (WE_END + WO_END) * 2;
constexpr size_t OFF_HB = OFF_Z + (size_t)T * 3840 * 2;
constexpr size_t OFF_MIX = OFF_HB + (size_t)T * 1024 * 2;
constexpr size_t OFF_PB = OFF_MIX + (size_t)T * 1024 * 2;
constexpr size_t OFF_LA = OFF_PB + (size_t)T * 256 * 2;
constexpr size_t OFF_EXT = OFF_LA + (size_t)T * 256 * 2;
constexpr size_t OFF_SS = OFF_EXT + (size_t)T * 512 * 2;
constexpr size_t WS_END = OFF_SS + (size_t)3 * T * 16 * 4;
constexpr size_t OFF_ACT = OFF_Z, OFF_UP = OFF_Z + (size_t)T * 2816 * 2;

struct Params { const float* in[39]; float* out; unsigned char* ws; };

__device__ __forceinline__ int lsg(int k) { asm volatile("" : "+s"(k)); return k; }
__device__ __forceinline__ float bflo(unsigned w) { return __uint_as_float(w << 16); }
__device__ __forceinline__ float bfhi(unsigned w) { return __uint_as_float(w & 0xffff0000u); }
__device__ __forceinline__ float bf2f(bf16_t u) { return __uint_as_float(((unsigned)u) << 16); }
__device__ __forceinline__ bf16_t f2bf(float f) { return (bf16_t)(cvt_pk_bf16(f, 0.f) & 0xffffu); }
__device__ __forceinline__ void unpack8(const u32x4 w, float (&f)[8]) { f[0] = bflo(w.x); f[1] = bfhi(w.x); f[2] = bflo(w.y); f[3] = bfhi(w.y); f[4] = bflo(w.z); f[5] = bfhi(w.z); f[6] = bflo(w.w); f[7] = bfhi(w.w); }
__device__ __forceinline__ u32x4 pack8(const float (&f)[8]) { u32x4 w; w.x = cvt_pk_bf16(f[0], f[1]); w.y = cvt_pk_bf16(f[2], f[3]); w.z = cvt_pk_bf16(f[4], f[5]); w.w = cvt_pk_bf16(f[6], f[7]); return w; }
__device__ __forceinline__ void unpack4(const u32x2 w, float (&f)[4]) { f[0] = bflo(w.x); f[1] = bfhi(w.x); f[2] = bflo(w.y); f[3] = bfhi(w.y); }
__device__ __forceinline__ float sigmoidf_(float x) { return 1.0f / (1.0f + __expf(-x)); }
__device__ __forceinline__ float siluf_(float x) { return x / (1.0f + __expf(-x)); }
__device__ __forceinline__ float softplusf_(float x) { return fmaxf(x, 0.f) + log1pf(__expf(-fabsf(x))); }
__device__ __forceinline__ float gelu_tanh(float x) { const float y = 0.7978845608028654f * (x + 0.044715f * x * x * x); const float t = 1.0f - 2.0f / (1.0f + __expf(2.0f * y)); return 0.5f * x * (1.0f + t); }
template <int CTRL> __device__ __forceinline__ float dppf(float v) { return __int_as_float(__builtin_amdgcn_update_dpp(0, __float_as_int(v), CTRL, 0xF, 0xF, true)); }
__device__ __forceinline__ float rowsum16(float v) { v += dppf<0xB1>(v); v += dppf<0x4E>(v); v += dppf<0x141>(v); v += dppf<0x140>(v); return v; }
__device__ __forceinline__ float rowsum8(float v) { v += dppf<0xB1>(v); v += dppf<0x4E>(v); v += dppf<0x141>(v); return v; }
__device__ __forceinline__ float wave_sum(float v) {
    v = rowsum16(v);
    const float a = __int_as_float(__builtin_amdgcn_readlane(__float_as_int(v), 0)), b = __int_as_float(__builtin_amdgcn_readlane(__float_as_int(v), 16)),
                c = __int_as_float(__builtin_amdgcn_readlane(__float_as_int(v), 32)), d = __int_as_float(__builtin_amdgcn_readlane(__float_as_int(v), 48));
    return (a + b) + (c + d);
}
__device__ __forceinline__ float quadsum(float s, int lane) {
    s += __int_as_float(__builtin_amdgcn_ds_bpermute((lane ^ 16) << 2, __float_as_int(s)));
    s += __int_as_float(__builtin_amdgcn_ds_bpermute((lane ^ 32) << 2, __float_as_int(s)));
    return s;
}
__device__ __forceinline__ u32x4 zero_u4() { unsigned z = 0u; asm volatile("" : "+v"(z)); u32x4 r = {z, z, z, z}; return r; }
__device__ __forceinline__ float rowss(const float* ss, int row) {
    const f32x4* p = (const f32x4*)(ss + (size_t)row * 16); const f32x4 a = p[0], b = p[1], c = p[2], d = p[3];
    return (((a[0] + a[1]) + (a[2] + a[3])) + ((b[0] + b[1]) + (b[2] + b[3]))) + (((c[0] + c[1]) + (c[2] + c[3])) + ((d[0] + d[1]) + (d[2] + d[3])));
}
#define LDS_FENCE() asm volatile("s_waitcnt lgkmcnt(0)" ::: "memory")

struct EpiZ {
    static constexpr bool PERM = true, AFTER_DRAIN = false;
    bf16_t* Z; int ldc; const float* ss;
    __device__ __forceinline__ void operator()(const f32x4 (&acc)[2][2][4][2], const Unit& u, int wr, int wc, int fr, int fq) const {
        const int row0 = u.pm * 256 + wr * 64 + fr, col0 = u.pn * 256 + wc * 32 + 8 * fq;
#pragma unroll
        for (int ai = 0; ai < 2; ++ai)
#pragma unroll
            for (int m = 0; m < 4; ++m) {
                const int row = row0 + ai * 128 + m * 16; const float rs = rsqrtf(rowss(ss, row) * (1.0f / 1024.0f) + 1e-6f);
                bf16_t* rowp = Z + (size_t)row * ldc + col0;
#pragma unroll
                for (int bj = 0; bj < 2; ++bj) { const f32x4 v0 = acc[ai][bj][m][0] * rs, v1 = acc[ai][bj][m][1] * rs;
                    u32x4 w; w.x = cvt_pk_bf16(v0[0], v0[1]); w.y = cvt_pk_bf16(v0[2], v0[3]); w.z = cvt_pk_bf16(v1[0], v1[1]); w.w = cvt_pk_bf16(v1[2], v1[3]);
                    *(u32x4*)(rowp + bj * 128) = w; } }
    }
};
struct EpiRes {
    static constexpr bool PERM = false, AFTER_DRAIN = false;
    float* H; bf16_t* HBp; float* ssn;
    __device__ __forceinline__ void operator()(const f32x4 (&acc)[2][2][4][2], const Unit& u, int wr, int wc, int fr, int fq) const {
        const int row0 = u.pm * 256 + wr * 64 + fr, col0 = u.pn * 256 + wc * 32 + 4 * fq;
#pragma unroll
        for (int ai = 0; ai < 2; ++ai)
#pragma unroll
            for (int m = 0; m < 4; ++m) {
                const int row = row0 + ai * 128 + m * 16; const size_t off = (size_t)row * 1024 + col0; float s = 0.f;
#pragma unroll
                for (int bj = 0; bj < 2; ++bj)
#pragma unroll
                    for (int n = 0; n < 2; ++n) { f32x4 hv = *(const f32x4*)(H + off + bj * 128 + n * 16); hv = hv + acc[ai][bj][m][n];
                        *(f32x4*)(H + off + bj * 128 + n * 16) = hv; s += (hv[0] * hv[0] + hv[1] * hv[1]) + (hv[2] * hv[2] + hv[3] * hv[3]);
                        u32x2 w; w.x = cvt_pk_bf16(hv[0], hv[1]); w.y = cvt_pk_bf16(hv[2], hv[3]); *(u32x2*)(HBp + off + bj * 128 + n * 16) = w; }
                s = quadsum(s, fq * 16 + fr);
                if (fq == 0) ssn[(size_t)row * 16 + u.pn * 4 + wc] = s;
                asm volatile("" ::: "memory"); }
    }
};
struct EpiGU {
    static constexpr bool PERM = true, AFTER_DRAIN = false;
    bf16_t* ACTp; const float* ss;
    __device__ __forceinline__ void operator()(const f32x4 (&acc)[2][2][4][2], const Unit& u, int wr, int wc, int fr, int fq) const {
        const int row0 = u.pm * 256 + wr * 64 + fr, col0 = u.pn * 128 + wc * 32 + 8 * fq;
#pragma unroll
        for (int ai = 0; ai < 2; ++ai)
#pragma unroll
            for (int m = 0; m < 4; ++m) {
                const int row = row0 + ai * 128 + m * 16; const float rs = rsqrtf(rowss(ss, row) * (1.0f / 1024.0f) + 1e-6f);
                float o[8];
#pragma unroll
                for (int n = 0; n < 2; ++n)
#pragma unroll
                    for (int q = 0; q < 4; ++q) { const float g = acc[ai][0][m][n][q] * rs, up = acc[ai][1][m][n][q] * rs; o[n * 4 + q] = siluf_(g) * up; }
                *(u32x4*)(ACTp + (size_t)row * FF + col0) = pack8(o); }
    }
};
struct EpiPle {
    static constexpr bool PERM = false, AFTER_DRAIN = false;
    float* H; bf16_t* HBp; float* ssn; const float* ss; const bf16_t* UPp;
    __device__ __forceinline__ void operator()(const f32x4 (&acc)[2][2][4][2], const Unit& u, int wr, int wc, int fr, int fq) const {
        const int row0 = u.pm * 256 + wr * 64 + fr, col0 = u.pn * 256 + wc * 32 + 4 * fq;
#pragma unroll
        for (int ai = 0; ai < 2; ++ai)
#pragma unroll
            for (int m = 0; m < 4; ++m) {
                const int row = row0 + ai * 128 + m * 16; const size_t off = (size_t)row * 1024 + col0; float s = 0.f;
                const float rs = rsqrtf(rowss(ss, row) * (1.0f / 1024.0f) + 1e-6f);
#pragma unroll
                for (int bj = 0; bj < 2; ++bj)
#pragma unroll
                    for (int n = 0; n < 2; ++n) { f32x4 hv = *(const f32x4*)(H + off + bj * 128 + n * 16); const u32x2 uw = *(const u32x2*)(UPp + off + bj * 128 + n * 16);
                        float uf[4]; unpack4(uw, uf); const f32x4 a = acc[ai][bj][m][n] * rs;
#pragma unroll
                        for (int q = 0; q < 4; ++q) hv[q] += sigmoidf_(a[q]) * uf[q];
                        *(f32x4*)(H + off + bj * 128 + n * 16) = hv; s += (hv[0] * hv[0] + hv[1] * hv[1]) + (hv[2] * hv[2] + hv[3] * hv[3]);
                        u32x2 w; w.x = cvt_pk_bf16(hv[0], hv[1]); w.y = cvt_pk_bf16(hv[2], hv[3]); *(u32x2*)(HBp + off + bj * 128 + n * 16) = w; }
                s = quadsum(s, fq * 16 + fr);
                if (fq == 0) ssn[(size_t)row * 16 + u.pn * 4 + wc] = s;
                asm volatile("" ::: "memory"); }
    }
};
struct EpiUp {
    static constexpr bool PERM = true, AFTER_DRAIN = false;
    bf16_t* O;
    __device__ __forceinline__ void operator()(const f32x4 (&acc)[2][2][4][2], const Unit& u, int wr, int wc, int fr, int fq) const {
        const int row0 = u.pm * 256 + wr * 64 + fr, col0 = u.pn * 256 + wc * 32 + 8 * fq;
#pragma unroll
        for (int ai = 0; ai < 2; ++ai)
#pragma unroll
            for (int m = 0; m < 4; ++m) {
                bf16_t* rowp = O + (size_t)(row0 + ai * 128 + m * 16) * 1024 + col0;
#pragma unroll
                for (int bj = 0; bj < 2; ++bj) { const f32x4 v0 = acc[ai][bj][m][0], v1 = acc[ai][bj][m][1];
                    u32x4 w; w.x = cvt_pk_bf16(v0[0], v0[1]); w.y = cvt_pk_bf16(v0[2], v0[3]); w.z = cvt_pk_bf16(v1[0], v1[1]); w.w = cvt_pk_bf16(v1[2], v1[3]);
                    *(u32x4*)(rowp + bj * 128) = w; } }
    }
};
struct EpiLora {
    static constexpr bool PERM = true, AFTER_DRAIN = false;
    bf16_t* HBp; bf16_t* MIXp;
    __device__ __forceinline__ void operator()(const f32x4 (&acc)[2][2][4][2], const Unit& u, int wr, int wc, int fr, int fq) const {
        const int row0 = u.pm * 256 + wr * 64 + fr; const int kind = u.pn >> 1; const int cc0 = (u.pn & 1) * 256 + wc * 32 + 8 * fq;
        bf16_t* dbase = ((kind == 2) ? (MIXp + 512) : (HBp + (kind == 1 ? 512 : 0))) + cc0;
#pragma unroll
        for (int ai = 0; ai < 2; ++ai)
#pragma unroll
            for (int m = 0; m < 4; ++m) {
                bf16_t* rowp = dbase + (size_t)(row0 + ai * 128 + m * 16) * 1024;
#pragma unroll
                for (int bj = 0; bj < 2; ++bj) { const f32x4 v0 = acc[ai][bj][m][0], v1 = acc[ai][bj][m][1];
                    u32x4 w; w.x = cvt_pk_bf16(v0[0], v0[1]); w.y = cvt_pk_bf16(v0[2], v0[3]); w.z = cvt_pk_bf16(v1[0], v1[1]); w.w = cvt_pk_bf16(v1[2], v1[3]);
                    *(u32x4*)(rowp + bj * 128) = w; } }
    }
};

__device__ __forceinline__ int nmap(int n, int mode, int roff) { return mode == 0 ? n + roff : (mode == 1 ? ((n >> 7) * 256 + (n & 127)) : ((n >> 7) * 256 + 128 + (n & 127))); }
__device__ __forceinline__ void tr_item(const float* W, int K, int N, bf16_t* dst, int ldk, int koff, int mode, int roff, const float* ks, LAS float* scr, int item, int lane) {
    const int nblk = (N + 31) >> 5, kb = item / nblk, nb = item - kb * nblk, k0 = 64 * kb, n0 = 32 * nb;
    const int nl = n0 + (lane & 31);
#pragma unroll 8
    for (int i = 0; i < 32; ++i) { const int kk = 2 * i + (lane >> 5); float v = 0.f;
        if (nl < N) { v = W[(size_t)(k0 + kk) * N + nl]; if (ks) v *= ks[k0 + kk]; }
        scr[kk * 33 + (lane & 31)] = v; }
    LDS_FENCE();
    const int c = lane & 7;
#pragma unroll
    for (int j = 0; j < 4; ++j) { const int nn = (lane >> 3) + 8 * j; const LAS float* s = scr + (8 * c) * 33 + nn;
        u32x4 o; o.x = cvt_pk_bf16(s[0 * 33], s[1 * 33]); o.y = cvt_pk_bf16(s[2 * 33], s[3 * 33]); o.z = cvt_pk_bf16(s[4 * 33], s[5 * 33]); o.w = cvt_pk_bf16(s[6 * 33], s[7 * 33]);
        if (n0 + nn < N) *(u32x4*)(dst + (size_t)nmap(n0 + nn, mode, roff) * ldk + koff + k0 + 8 * c) = o; }
    LDS_FENCE();
}
__device__ __forceinline__ void ph_convert(const Params& P, int L, LAS unsigned char* lds, int tid) {
    const int lane = tid & 63, wid = tid >> 6;
    const int gw = blockIdx.x * 8 + wid, NGW = gridDim.x * 8, gtid = blockIdx.x * 512 + tid, NTH = gridDim.x * 512;
    LAS float* scr = (LAS float*)(lds + wid * 8704);
    const int j = L >> 1; const bool odd = (L & 1) != 0;
    bf16_t* Wb = (bf16_t*)(P.ws + OFF_W) + (odd ? WO_BASE : 0);
    int it = gw;
#define JOB(Wsrc, K_, N_, dst_, ldk_, koff_, mode_, roff_, ks_) { const int ni = ((K_) / 64) * (((N_) + 31) / 32); \
        for (; it < ni; it += NGW) tr_item((Wsrc), (K_), (N_), (dst_), (ldk_), (koff_), (mode_), (roff_), (ks_), scr, it, lane); it -= ni; }
    if (!odd) {
        JOB(P.in[lsg(6)] + (size_t)j * 1024 * 3080, 1024, 3080, Wb + WE_IN, 1024, 0, 0, 0, P.in[lsg(2)] + L * 1024)
        JOB(P.in[lsg(18)] + (size_t)j * 1024 * 1024, 1024, 1024, Wb + WE_OUT, 1024, 0, 0, 0, (const float*)nullptr)
    } else {
        JOB(P.in[lsg(19)] + (size_t)j * 1024 * 3840, 1024, 3840, Wb + WO_IN, 1024, 0, 0, 0, P.in[lsg(2)] + L * 1024)
        JOB(P.in[lsg(24)] + (size_t)j * 64 * 512, 64, 512, Wb + WO_LORA, 256, 0, 0, 0, (const float*)nullptr)
        JOB(P.in[lsg(26)] + (size_t)j * 64 * 512, 64, 512, Wb + WO_LORA, 256, 64, 0, 512, (const float*)nullptr)
        JOB(P.in[lsg(27)] + (size_t)j * 128 * 512, 128, 512, Wb + WO_LORA, 256, 128, 0, 1024, (const float*)nullptr)
        JOB(P.in[lsg(33)] + (size_t)j * 1024 * 1024, 1024, 1024, Wb + WO_OUT, 1024, 0, 0, 0, (const float*)nullptr)
    }
    bf16_t* Wgu = Wb + (odd ? WO_GU : WE_GU); bf16_t* Wdn = Wb + (odd ? WO_DN : WE_DN); bf16_t* Wpg = Wb + (odd ? WO_PG : WE_PG); bf16_t* Wpu = Wb + (odd ? WO_PU : WE_PU);
    JOB(P.in[lsg(34)] + (size_t)L * 1024 * 2816, 1024, 2816, Wgu, 1024, 0, 1, 0, P.in[lsg(3)] + L * 1024)
    JOB(P.in[lsg(35)] + (size_t)L * 1024 * 2816, 1024, 2816, Wgu, 1024, 0, 2, 0, P.in[lsg(3)] + L * 1024)
    JOB(P.in[lsg(36)] + (size_t)L * 2816 * 1024, 2816, 1024, Wdn, 2816, 0, 0, 0, (const float*)nullptr)
    JOB(P.in[lsg(38)] + (size_t)L * 1024 * 1024, 1024, 1024, Wpg, 1024, 0, 0, 0, P.in[lsg(4)] + L * 1024)
    JOB(P.in[lsg(37)] + (size_t)L * 256 * 1024, 256, 1024, Wpu, 256, 0, 0, 0, (const float*)nullptr)
#undef JOB
    const u32x4 zero4 = zero_u4();
    if (!odd) {
        u32x4* zp = (u32x4*)(Wb + WE_IN + (size_t)3080 * 1024);
        for (int i = gtid; i < 248 * 128; i += NTH) zp[i] = zero4;
    } else {
        u32x4* zp = (u32x4*)(Wb + WO_LORA);
        for (int ch = gtid; ch < 1536 * 32; ch += NTH) { const int n = ch >> 5, c = ch & 31, kind = n >> 9;
            const bool live = kind == 0 ? (c < 8) : (kind == 1 ? (c >= 8 && c < 16) : (c >= 16));
            if (!live) zp[ch] = zero4; }
    }
}

__device__ __forceinline__ void ph_convert_p(const Params& P, int L, int tid) {
    const int gtid = blockIdx.x * 512 + tid, NTH = gridDim.x * 512;
    const float* p = P.in[lsg(1)] + (size_t)L * T * 256; u32x4* pb = (u32x4*)(P.ws + OFF_PB);
    for (int i = gtid; i < T * 32; i += NTH) { const f32x4 a = *(const f32x4*)(p + (size_t)i * 8), b = *(const f32x4*)(p + (size_t)i * 8 + 4);
        u32x4 w; w.x = cvt_pk_bf16(a[0], a[1]); w.y = cvt_pk_bf16(a[2], a[3]); w.z = cvt_pk_bf16(b[0], b[1]); w.w = cvt_pk_bf16(b[2], b[3]); pb[i] = w; }
}

__device__ __forceinline__ void ph_prologue(const Params& P, int tid) {
    const int lane = tid & 63, gw = blockIdx.x * 8 + (tid >> 6), NGW = gridDim.x * 8;
    const float* x = P.in[lsg(0)]; float* h = P.out; bf16_t* hb = (bf16_t*)(P.ws + OFF_HB); float* ssA = (float*)(P.ws + OFF_SS);
    for (int row = gw; row < T; row += NGW) {
        const f32x4* xr = (const f32x4*)(x + (size_t)row * 1024) + lane; f32x4* hr = (f32x4*)(h + (size_t)row * 1024) + lane; u32x2* br = (u32x2*)(hb + (size_t)row * 1024) + lane;
        float s = 0.f;
#pragma unroll
        for (int q = 0; q < 4; ++q) { const f32x4 v = xr[64 * q]; s += (v[0] * v[0] + v[1] * v[1]) + (v[2] * v[2] + v[3] * v[3]); hr[64 * q] = v;
            u32x2 w; w.x = cvt_pk_bf16(v[0], v[1]); w.y = cvt_pk_bf16(v[2], v[3]); br[64 * q] = w; }
        s = wave_sum(s); if (lane < 16) ssA[(size_t)row * 16 + lane] = (lane == 0) ? s : 0.f;
    }
}
__device__ __forceinline__ void zero_f32(float* p, int n, int tid) { for (int i = blockIdx.x * 512 + tid; i < n; i += gridDim.x * 512) p[i] = 0.f; }
__device__ __forceinline__ void ph_final(const Params& P, int tid) {
    const int lane = tid & 63, gw = blockIdx.x * 8 + (tid >> 6), NGW = gridDim.x * 8;
    float* h = P.out; const float* ssA = (const float*)(P.ws + OFF_SS); const float* nw = P.in[lsg(5)];
    f32x4 w4[4];
#pragma unroll
    for (int q = 0; q < 4; ++q) w4[q] = *((const f32x4*)nw + lane + 64 * q);
    for (int row = gw; row < T; row += NGW) {
        f32x4* hr = (f32x4*)(h + (size_t)row * 1024) + lane; const float rs = rsqrtf(rowss(ssA, row) * (1.0f / 1024.0f) + 1e-6f);
#pragma unroll
        for (int q = 0; q < 4; ++q) { f32x4 v = hr[64 * q]; v = v * rs * w4[q]; hr[64 * q] = v; }
    }
}

__device__ __forceinline__ void ph_rg_prep(const Params& P, int j, LAS unsigned char* lds, int tid) {
    const int lane = tid & 63, g = tid >> 6, quad = lane >> 4, fr = lane & 15;
    const bf16_t* Z = (const bf16_t*)(P.ws + OFF_Z); bf16_t* HB = (bf16_t*)(P.ws + OFF_HB);
    LAS bf16_t* xb = (LAS bf16_t*)lds;
    const float* wr_ = P.in[lsg(9)] + (size_t)(j * 8 + g) * 4096; const float* wi_ = P.in[lsg(11)] + (size_t)(j * 8 + g) * 4096;
    bf16x8 Br[4][2], Bi[4][2];
#pragma unroll
    for (int nt = 0; nt < 4; ++nt)
#pragma unroll
        for (int ks = 0; ks < 2; ++ks) {
            float a[8], b[8];
#pragma unroll
            for (int q = 0; q < 8; ++q) { const int i = ks * 32 + quad * 8 + q, jj = nt * 16 + fr; a[q] = wr_[i * 64 + jj]; b[q] = wi_[i * 64 + jj]; }
            const u32x4 pa = pack8(a), pb = pack8(b); Br[nt][ks] = __builtin_bit_cast(bf16x8, pa); Bi[nt][ks] = __builtin_bit_cast(bf16x8, pb);
        }
    const int c0 = (tid & 63) * 8;
    float cw[4][8], cb[8];
#pragma unroll
    for (int k = 0; k < 4; ++k)
#pragma unroll
        for (int q = 0; q < 8; ++q) cw[k][q] = P.in[lsg(7)][(size_t)(j * 4 + k) * 512 + c0 + q];
#pragma unroll
    for (int q = 0; q < 8; ++q) cb[q] = P.in[lsg(8)][j * 512 + c0 + q];
    float ebr[4], ebi[4], espl[4];
#pragma unroll
    for (int nt = 0; nt < 4; ++nt) { const int col = g * 64 + nt * 16 + fr; ebr[nt] = P.in[lsg(10)][j * 512 + col]; ebi[nt] = P.in[lsg(12)][j * 512 + col]; espl[nt] = softplusf_(-P.in[lsg(13)][j * 512 + col]); }

    for (int tile = blockIdx.x; tile < T / 64; tile += gridDim.x) {
        const int t0 = tile * 64, s0 = t0 & (SEQ - 1);
#pragma unroll 2
        for (int it = 0; it < 8; ++it) {
            const int tok = it * 8 + (tid >> 6);
            float a8[8];
#pragma unroll
            for (int q = 0; q < 8; ++q) a8[q] = cb[q];
#pragma unroll
            for (int k = 0; k < 4; ++k) {
                if (s0 + tok - 3 + k >= 0) { const u32x4 w = *(const u32x4*)(Z + (size_t)(t0 + tok - 3 + k) * EVN + c0); float xf[8]; unpack8(w, xf);
#pragma unroll
                    for (int q = 0; q < 8; ++q) a8[q] += cw[k][q] * xf[q]; } }
            *(LAS u32x4*)(xb + tok * 520 + c0) = pack8(a8);
        }
        __syncthreads();
#pragma unroll 1
        for (int mt = 0; mt < 4; ++mt) {
            f32x4 dr[4], di[4];
#pragma unroll
            for (int nt = 0; nt < 4; ++nt) { dr[nt] = (f32x4){0.f, 0.f, 0.f, 0.f}; di[nt] = (f32x4){0.f, 0.f, 0.f, 0.f}; }
#pragma unroll
            for (int ks = 0; ks < 2; ++ks) {
                const bf16x8 a = *(const LAS bf16x8*)(xb + (mt * 16 + fr) * 520 + g * 64 + ks * 32 + quad * 8);
#pragma unroll
                for (int nt = 0; nt < 4; ++nt) { dr[nt] = __builtin_amdgcn_mfma_f32_16x16x32_bf16(a, Br[nt][ks], dr[nt], 0, 0, 0); di[nt] = __builtin_amdgcn_mfma_f32_16x16x32_bf16(a, Bi[nt][ks], di[nt], 0, 0, 0); }
            }
#pragma unroll
            for (int nt = 0; nt < 4; ++nt) {
                const int col = g * 64 + nt * 16 + fr;
#pragma unroll
                for (int q = 0; q < 4; ++q) {
                    const int tok = mt * 16 + quad * 4 + q; const float xv = bf2f(xb[tok * 520 + col]);
                    const float r = sigmoidf_(dr[nt][q] + ebr[nt]), ig = sigmoidf_(di[nt][q] + ebi[nt]);
                    const float la = -8.0f * r * espl[nt];
                    const float mult = (s0 + tok == 0) ? 1.0f : sqrtf(-expm1f(2.0f * la));
                    const float uu = mult * ig * xv;
                    HB[(size_t)(t0 + tok) * 1024 + col] = f2bf(la); HB[(size_t)(t0 + tok) * 1024 + 512 + col] = f2bf(uu);
                }
            }
        }
        __syncthreads();
    }
}

__device__ __forceinline__ void ph_rg_scan(const Params& P, int task, LAS unsigned char* lds, int tid) {
    const int b = task >> 4, c = (task & 15) * 32 + (tid & 31), seg = tid >> 5;
    const bf16_t* Z = (const bf16_t*)(P.ws + OFF_Z); const bf16_t* HB = (const bf16_t*)(P.ws + OFF_HB); bf16_t* MIX = (bf16_t*)(P.ws + OFF_MIX);
    LAS float* sSL = (LAS float*)lds; LAS float* sH = sSL + 512;
    const size_t tb = (size_t)b * SEQ + (size_t)seg * 256;
    float H = 0.f, SL = 0.f;
#pragma unroll 8
    for (int i = 0; i < 256; ++i) { const float la = bf2f(HB[(tb + i) * 1024 + c]), uu = bf2f(HB[(tb + i) * 1024 + 512 + c]); H = __expf(la) * H + uu; SL += la; }
    sSL[tid] = SL; sH[tid] = H;
    __syncthreads();
    float hc = 0.f;
    for (int s2 = 0; s2 < seg; ++s2) hc = __expf(sSL[s2 * 32 + (tid & 31)]) * hc + sH[s2 * 32 + (tid & 31)];
    H = hc;
#pragma unroll 8
    for (int i = 0; i < 256; ++i) { const float la = bf2f(HB[(tb + i) * 1024 + c]), uu = bf2f(HB[(tb + i) * 1024 + 512 + c]); H = __expf(la) * H + uu;
        const float ya = bf2f(Z[(tb + i) * EVN + 512 + c]); MIX[(tb + i) * 1024 + c] = f2bf(H * gelu_tanh(ya)); }
    __syncthreads();
}

__device__ __forceinline__ void ph_gdn(const Params& P, int j, int task, LAS unsigned char* lds, int tid) {
    const int lane = tid & 63, wid = tid >> 6, quad = lane >> 4, il = lane & 15;
    const int bh = task >> 2, b = bh >> 2, hh = bh & 3, cgp = task & 3;
    const bf16_t* Z = (const bf16_t*)(P.ws + OFF_Z); bf16_t* MIX = (bf16_t*)(P.ws + OFF_MIX);
    LAS bf16_t* raw = (LAS bf16_t*)lds;
    LAS float* sq = (LAS float*)(lds + 38912);
    LAS float* sk = sq + 64 * 128; LAS float* sv = sk + 64 * 128; LAS float* seg = sv + 64 * 32; LAS float* sbt = seg + 64; LAS bf16_t* sout = (LAS bf16_t*)(sbt + 64);
    const int which = (tid >> 4) & 1, ch0 = il * 8;
    float cw[4][8], cwv[4][8];
#pragma unroll
    for (int k = 0; k < 4; ++k)
#pragma unroll
        for (int q = 0; q < 8; ++q) { cw[k][q] = P.in[lsg(14)][(size_t)(j * 4 + k) * 1536 + which * 512 + hh * 128 + ch0 + q];
            cwv[k][q] = P.in[lsg(14)][(size_t)(j * 4 + k) * 1536 + 1024 + hh * 128 + cgp * 32 + (tid & 3) * 8 + q]; }
    const float nalog = -__expf(P.in[lsg(15)][j * 4 + hh]), dtb = P.in[lsg(16)][j * 4 + hh];
    float S[8];
#pragma unroll
    for (int q = 0; q < 8; ++q) S[q] = 0.f;
    u32x4 R[5];
    const u32x4 zero4 = zero_u4();
#define GDN_LOAD(cc) { const int t0_ = b * SEQ + (cc) * 64; _Pragma("unroll") for (int i = 0; i < 5; ++i) { const int p = tid + 512 * i; const int rr = p / 36, pc = p - rr * 36; \
        const bool valid = (p < 2412) && ((cc) * 64 - 3 + rr >= 0); \
        const int col = pc < 16 ? (1024 + hh * 128 + pc * 8) : (pc < 32 ? (1536 + hh * 128 + (pc - 16) * 8) : (2048 + hh * 128 + cgp * 32 + (pc - 32) * 8)); \
        R[i] = valid ? *(const u32x4*)(Z + (size_t)(t0_ - 3 + rr) * EVN + col) : zero4; } }
    GDN_LOAD(0)
#pragma unroll 1
    for (int c = 0; c < 64; ++c) {
        const int t0 = b * SEQ + c * 64;
#pragma unroll
        for (int i = 0; i < 5; ++i) { const int p = tid + 512 * i; if (p < 2412) { const int rr = p / 36, pc = p - rr * 36; *(LAS u32x4*)(raw + rr * 288 + pc * 8) = R[i]; } }
        __syncthreads();
#pragma unroll 1
        for (int it = 0; it < 4; ++it) {
            const int tok = (it * 32 + (tid >> 4)) >> 1;
            float a8[8];
#pragma unroll
            for (int q = 0; q < 8; ++q) a8[q] = 0.f;
#pragma unroll
            for (int k = 0; k < 4; ++k) { const u32x4 w = *(const LAS u32x4*)(raw + (tok + k) * 288 + which * 128 + ch0); float xf[8]; unpack8(w, xf);
#pragma unroll
                for (int q = 0; q < 8; ++q) a8[q] += cw[k][q] * xf[q]; }
            float ss = 0.f;
#pragma unroll
            for (int q = 0; q < 8; ++q) { a8[q] = siluf_(a8[q]); ss += a8[q] * a8[q]; }
            ss = rowsum16(ss);
            const float sc = rsqrtf(ss + 1e-6f) * (which == 0 ? 0.08838834764831845f : 1.0f);
            LAS float* dst = (which ? sk : sq) + tok * 128 + ch0;
            *(LAS f32x4*)dst = (f32x4){a8[0] * sc, a8[1] * sc, a8[2] * sc, a8[3] * sc}; *(LAS f32x4*)(dst + 4) = (f32x4){a8[4] * sc, a8[5] * sc, a8[6] * sc, a8[7] * sc};
        }
        if (tid < 256) {
            const int tok = tid >> 2, vch = (tid & 3) * 8; float a8[8];
#pragma unroll
            for (int q = 0; q < 8; ++q) a8[q] = 0.f;
#pragma unroll
            for (int k = 0; k < 4; ++k) { const u32x4 w = *(const LAS u32x4*)(raw + (tok + k) * 288 + 256 + vch); float xf[8]; unpack8(w, xf);
#pragma unroll
                for (int q = 0; q < 8; ++q) a8[q] += cwv[k][q] * xf[q]; }
            LAS float* dst = sv + tok * 32 + vch;
            *(LAS f32x4*)dst = (f32x4){siluf_(a8[0]), siluf_(a8[1]), siluf_(a8[2]), siluf_(a8[3])}; *(LAS f32x4*)(dst + 4) = (f32x4){siluf_(a8[4]), siluf_(a8[5]), siluf_(a8[6]), siluf_(a8[7])};
        } else if (tid < 320) {
            const int tok = tid - 256; const size_t zr = (size_t)(t0 + tok) * EVN;
            const float a_in = bf2f(Z[zr + 3072 + hh]), b_in = bf2f(Z[zr + 3076 + hh]);
            seg[tok] = __expf(nalog * softplusf_(a_in + dtb)); sbt[tok] = sigmoidf_(b_in);
        }
        __syncthreads();
        if (c + 1 < 64) GDN_LOAD(c + 1)
#pragma unroll 4
        for (int s = 0; s < 64; ++s) {
            const f32x4 k0 = *(const LAS f32x4*)(sk + s * 128 + ch0), k1 = *(const LAS f32x4*)(sk + s * 128 + ch0 + 4);
            const f32x4 q0 = *(const LAS f32x4*)(sq + s * 128 + ch0), q1 = *(const LAS f32x4*)(sq + s * 128 + ch0 + 4);
            const float v = sv[s * 32 + wid * 4 + quad], eg = seg[s], bt = sbt[s];
            float pk = (k0[0] * S[0] + k0[1] * S[1]) + (k0[2] * S[2] + k0[3] * S[3]) + ((k1[0] * S[4] + k1[1] * S[5]) + (k1[2] * S[6] + k1[3] * S[7]));
            pk = rowsum16(pk);
            const float dl = bt * (v - eg * pk);
            S[0] = eg * S[0] + k0[0] * dl; S[1] = eg * S[1] + k0[1] * dl; S[2] = eg * S[2] + k0[2] * dl; S[3] = eg * S[3] + k0[3] * dl;
            S[4] = eg * S[4] + k1[0] * dl; S[5] = eg * S[5] + k1[1] * dl; S[6] = eg * S[6] + k1[2] * dl; S[7] = eg * S[7] + k1[3] * dl;
            float po = (q0[0] * S[0] + q0[1] * S[1]) + (q0[2] * S[2] + q0[3] * S[3]) + ((q1[0] * S[4] + q1[1] * S[5]) + (q1[2] * S[6] + q1[3] * S[7]));
            po = rowsum16(po);
            if (il == 0) sout[s * 32 + wid * 4 + quad] = f2bf(po);
        }
        __syncthreads();
        if (tid < 256) { const int s = tid >> 2, pc = tid & 3; *(u32x4*)(MIX + (size_t)(t0 + s) * 1024 + 512 + hh * 128 + cgp * 32 + pc * 8) = *(const LAS u32x4*)(sout + s * 32 + pc * 8); }
    }
#undef GDN_LOAD
    __syncthreads();
}

__device__ __forceinline__ void ph_gdn_post(const Params& P, int j, int tid) {
    const int lane = tid & 63, gw = blockIdx.x * 8 + (tid >> 6), NGW = gridDim.x * 8;
    const bf16_t* Z = (const bf16_t*)(P.ws + OFF_Z); bf16_t* MIX = (bf16_t*)(P.ws + OFF_MIX);
    const int head = lane >> 4, il = lane & 15;
    float nw[8];
#pragma unroll
    for (int q = 0; q < 8; ++q) nw[q] = P.in[lsg(17)][j * 128 + il * 8 + q];
    for (int t = gw; t < T; t += NGW) {
        bf16_t* op = MIX + (size_t)t * 1024 + 512 + head * 128 + il * 8;
        float o[8], zg[8]; unpack8(*(const u32x4*)op, o); unpack8(*(const u32x4*)(Z + (size_t)t * EVN + 2560 + head * 128 + il * 8), zg);
        float ss = 0.f;
#pragma unroll
        for (int q = 0; q < 8; ++q) ss += o[q] * o[q];
        ss = rowsum16(ss); const float rs = rsqrtf(ss * (1.0f / 128.0f) + 1e-6f);
#pragma unroll
        for (int q = 0; q < 8; ++q) o[q] = o[q] * rs * nw[q] * siluf_(zg[q]);
        *(u32x4*)op = pack8(o);
    }
}

__device__ __forceinline__ void ph_lora_prep(const Params& P, int j, int tid) {
    const bf16_t* Z = (const bf16_t*)(P.ws + OFF_Z); bf16_t* LA = (bf16_t*)(P.ws + OFF_LA);
    const int grp = tid & 31;
    float mu[8];
#pragma unroll
    for (int q = 0; q < 8; ++q) mu[q] = P.in[lsg(22)][(size_t)j * 1792 + 1536 + grp * 8 + q];
    for (int item = blockIdx.x * 512 + tid; item < T * 32; item += gridDim.x * 512) {
        const int t = item >> 5; const size_t zo = (size_t)t * ODN + 2048 + 1536 + grp * 8;
        float cur[8], prv[8]; unpack8(*(const u32x4*)(Z + zo), cur);
        if ((t & (SEQ - 1)) != 0) unpack8(*(const u32x4*)(Z + zo - ODN), prv); else {
#pragma unroll
            for (int q = 0; q < 8; ++q) prv[q] = 0.f; }
        float o[8];
#pragma unroll
        for (int q = 0; q < 8; ++q) { const float m = cur[q] + mu[q] * (prv[q] - cur[q]); o[q] = grp < 8 ? tanhf(m) : (grp < 16 ? m : sigmoidf_(m)); }
        *(u32x4*)(LA + (size_t)t * 256 + grp * 8) = pack8(o);
    }
}

__device__ __forceinline__ void ph_hgrn(const Params& P, int j, int task, LAS unsigned char* lds, int tid) {
    const int lane = tid & 63, wid = tid >> 6, quad = lane >> 4, il = lane & 15;
    const int bh = task >> 2, b = bh >> 2, hh = bh & 3, cgp = task & 3;
    const bf16_t* Z = (const bf16_t*)(P.ws + OFF_Z); bf16_t* MIX = (bf16_t*)(P.ws + OFF_MIX);
    LAS float* sq = (LAS float*)lds; LAS float* sf = sq + 64 * 128; LAS float* sv = sf + 64 * 128; LAS bf16_t* sout = (LAS bf16_t*)(sv + 64 * 32); LAS float* slb = (LAS float*)(lds + 77824);
    if (tid < 128) { float lb = 0.f; if (j > 0) { const float x0 = P.in[lsg(20)][hh * 128 + tid], x1 = P.in[lsg(20)][512 + hh * 128 + tid]; lb = fmaxf(sigmoidf_(x1 - x0), 0.f); } slb[tid] = lb; }
    __syncthreads();
    const int ch0 = il * 8;
    float S[8];
#pragma unroll
    for (int q = 0; q < 8; ++q) S[q] = 0.f;
    u32x4 R[5];
    const u32x4 zero4 = zero_u4();
#define HG_LOAD(cc) { const int t0_ = b * SEQ + (cc) * 64; _Pragma("unroll") for (int i = 0; i < 5; ++i) { const int p = tid + 512 * i; const int rr = p / 36, pc = p - rr * 36; \
        const int col = pc < 16 ? (hh * 128 + pc * 8) : (pc < 32 ? (512 + hh * 128 + (pc - 16) * 8) : (1024 + hh * 128 + cgp * 32 + (pc - 32) * 8)); \
        R[i] = (p < 2304) ? *(const u32x4*)(Z + (size_t)(t0_ + rr) * ODN + col) : zero4; } }
    HG_LOAD(0)
#pragma unroll 1
    for (int c = 0; c < 64; ++c) {
        const int t0 = b * SEQ + c * 64;
#pragma unroll
        for (int i = 0; i < 5; ++i) { const int p = tid + 512 * i; if (p < 2304) { const int rr = p / 36, pc = p - rr * 36; float xf[8]; unpack8(R[i], xf);
            if (pc < 16) {
#pragma unroll
                for (int q = 0; q < 8; ++q) xf[q] = siluf_(xf[q]);
                LAS float* dst = sq + rr * 128 + pc * 8; *(LAS f32x4*)dst = (f32x4){xf[0], xf[1], xf[2], xf[3]}; *(LAS f32x4*)(dst + 4) = (f32x4){xf[4], xf[5], xf[6], xf[7]};
            } else if (pc < 32) { const int d0 = (pc - 16) * 8;
#pragma unroll
                for (int q = 0; q < 8; ++q) { const float lb = slb[d0 + q]; xf[q] = lb + (1.0f - lb) * sigmoidf_(xf[q]); }
                LAS float* dst = sf + rr * 128 + d0; *(LAS f32x4*)dst = (f32x4){xf[0], xf[1], xf[2], xf[3]}; *(LAS f32x4*)(dst + 4) = (f32x4){xf[4], xf[5], xf[6], xf[7]};
            } else { LAS float* dst = sv + rr * 32 + (pc - 32) * 8; *(LAS f32x4*)dst = (f32x4){xf[0], xf[1], xf[2], xf[3]}; *(LAS f32x4*)(dst + 4) = (f32x4){xf[4], xf[5], xf[6], xf[7]}; } } }
        __syncthreads();
        if (c + 1 < 64) HG_LOAD(c + 1)
#pragma unroll 4
        for (int s = 0; s < 64; ++s) {
            const f32x4 f0 = *(const LAS f32x4*)(sf + s * 128 + ch0), f1 = *(const LAS f32x4*)(sf + s * 128 + ch0 + 4);
            const f32x4 q0 = *(const LAS f32x4*)(sq + s * 128 + ch0), q1 = *(const LAS f32x4*)(sq + s * 128 + ch0 + 4);
            const float v = sv[s * 32 + wid * 4 + quad];
            S[0] = f0[0] * S[0] + (1.0f - f0[0]) * v; S[1] = f0[1] * S[1] + (1.0f - f0[1]) * v; S[2] = f0[2] * S[2] + (1.0f - f0[2]) * v; S[3] = f0[3] * S[3] + (1.0f - f0[3]) * v;
            S[4] = f1[0] * S[4] + (1.0f - f1[0]) * v; S[5] = f1[1] * S[5] + (1.0f - f1[1]) * v; S[6] = f1[2] * S[6] + (1.0f - f1[2]) * v; S[7] = f1[3] * S[7] + (1.0f - f1[3]) * v;
            float po = (q0[0] * S[0] + q0[1] * S[1]) + (q0[2] * S[2] + q0[3] * S[3]) + ((q1[0] * S[4] + q1[1] * S[5]) + (q1[2] * S[6] + q1[3] * S[7]));
            po = rowsum16(po);
            if (il == 0) sout[s * 32 + wid * 4 + quad] = f2bf(po);
        }
        __syncthreads();
        if (tid < 256) { const int s = tid >> 2, pc = tid & 3; *(u32x4*)(MIX + (size_t)(t0 + s) * 1024 + hh * 128 + cgp * 32 + pc * 8) = *(const LAS u32x4*)(sout + s * 32 + pc * 8); }
    }
#undef HG_LOAD
    __syncthreads();
}

__device__ __forceinline__ void ph_rwkv(const Params& P, int j, int task, LAS unsigned char* lds, int tid) {
    const int lane = tid & 63, wid = tid >> 6, quad = lane >> 4, il = lane & 15;
    const int bh = task >> 1, b = bh >> 3, hh = bh & 7, half = task & 1;
    const bf16_t* Z = (const bf16_t*)(P.ws + OFF_Z); const bf16_t* HB = (const bf16_t*)(P.ws + OFF_HB); bf16_t* EXT = (bf16_t*)(P.ws + OFF_EXT);
    LAS bf16_t* raw1 = (LAS bf16_t*)lds;
    LAS bf16_t* raw2 = (LAS bf16_t*)(lds + 20992);
    LAS float* sr = (LAS float*)(lds + 37376); LAS float* skp = sr + 4096; LAS float* snk = skp + 4096; LAS float* sbb = snk + 4096; LAS float* sw = sbb + 4096; LAS float* sv = sw + 4096;
    LAS bf16_t* sout = (LAS bf16_t*)(sv + 2048);
    const int j0 = il * 4, v4 = (tid & 7) * 4;
    float mur[4], muk[4], muv[4], kkw[4], kaw[4], w0v[4], a0v[4];
#pragma unroll
    for (int q = 0; q < 4; ++q) { mur[q] = P.in[lsg(22)][(size_t)j * 1792 + hh * 64 + j0 + q]; muk[q] = P.in[lsg(22)][(size_t)j * 1792 + 512 + hh * 64 + j0 + q];
        muv[q] = P.in[lsg(22)][(size_t)j * 1792 + 1024 + hh * 64 + half * 32 + v4 + q]; kkw[q] = P.in[lsg(28)][j * 512 + hh * 64 + j0 + q]; kaw[q] = P.in[lsg(29)][j * 512 + hh * 64 + j0 + q];
        w0v[q] = P.in[lsg(23)][j * 512 + hh * 64 + j0 + q]; a0v[q] = P.in[lsg(25)][j * 512 + hh * 64 + j0 + q]; }
    float S[4] = {0.f, 0.f, 0.f, 0.f};
    u32x4 R[5];
    const u32x4 zero4 = zero_u4();
#define R7_LOAD(cc) { const int t0_ = b * SEQ + (cc) * 64; _Pragma("unroll") for (int i = 0; i < 5; ++i) { const int p = tid + 512 * i; u32x4 val = zero4; \
        if (p < 1300) { const int rr = p / 20, pc = p - rr * 20; if ((cc) * 64 - 1 + rr >= 0) { \
            const int col = pc < 8 ? (2048 + hh * 64 + pc * 8) : (pc < 16 ? (2560 + hh * 64 + (pc - 8) * 8) : (3072 + hh * 64 + half * 32 + (pc - 16) * 8)); \
            val = *(const u32x4*)(Z + (size_t)(t0_ - 1 + rr) * ODN + col); } } \
        else if (p < 2324) { const int p2 = p - 1300, rr = p2 >> 4, pc = p2 & 15; \
            val = *(const u32x4*)(HB + (size_t)(t0_ + rr) * 1024 + (pc < 8 ? (hh * 64 + pc * 8) : (512 + hh * 64 + (pc - 8) * 8))); } \
        R[i] = val; } }
    R7_LOAD(0)
#pragma unroll 1
    for (int c = 0; c < 64; ++c) {
        const int t0 = b * SEQ + c * 64;
#pragma unroll
        for (int i = 0; i < 5; ++i) { const int p = tid + 512 * i;
            if (p < 1300) { const int rr = p / 20, pc = p - rr * 20; *(LAS u32x4*)(raw1 + rr * 160 + pc * 8) = R[i]; }
            else if (p < 2324) { const int p2 = p - 1300, rr = p2 >> 4, pc = p2 & 15; *(LAS u32x4*)(raw2 + rr * 128 + pc * 8) = R[i]; } }
        __syncthreads();
#pragma unroll 1
        for (int it = 0; it < 2; ++it) {
            const int tok = it * 32 + (tid >> 4);
            float rc[4], rp[4], kc[4], kp_[4], lw[4], av[4];
            unpack4(*(const LAS u32x2*)(raw1 + (tok + 1) * 160 + j0), rc); unpack4(*(const LAS u32x2*)(raw1 + tok * 160 + j0), rp);
            unpack4(*(const LAS u32x2*)(raw1 + (tok + 1) * 160 + 64 + j0), kc); unpack4(*(const LAS u32x2*)(raw1 + tok * 160 + 64 + j0), kp_);
            unpack4(*(const LAS u32x2*)(raw2 + tok * 128 + j0), lw); unpack4(*(const LAS u32x2*)(raw2 + tok * 128 + 64 + j0), av);
            float r[4], k[4], kk[4], ss = 0.f;
#pragma unroll
            for (int q = 0; q < 4; ++q) { av[q] = sigmoidf_(av[q] + a0v[q]); lw[q] = -0.6065306597126334f * sigmoidf_(lw[q] + w0v[q]); r[q] = rc[q] + mur[q] * (rp[q] - rc[q]); k[q] = kc[q] + muk[q] * (kp_[q] - kc[q]); kk[q] = k[q] * kkw[q]; ss += kk[q] * kk[q]; }
            ss = rowsum16(ss); const float sc = rsqrtf(ss + 1e-6f);
            f32x4 o_r, o_kp, o_nk, o_bb, o_w;
#pragma unroll
            for (int q = 0; q < 4; ++q) { const float kn = kk[q] * sc; o_r[q] = r[q]; o_kp[q] = k[q] * (1.0f + (av[q] - 1.0f) * kaw[q]); o_nk[q] = -kn; o_bb[q] = kn * av[q]; o_w[q] = __expf(lw[q]); }
            *(LAS f32x4*)(sr + tok * 64 + j0) = o_r; *(LAS f32x4*)(skp + tok * 64 + j0) = o_kp; *(LAS f32x4*)(snk + tok * 64 + j0) = o_nk; *(LAS f32x4*)(sbb + tok * 64 + j0) = o_bb; *(LAS f32x4*)(sw + tok * 64 + j0) = o_w;
        }
        { const int tok = tid >> 3; float vc[4], vp[4]; unpack4(*(const LAS u32x2*)(raw1 + (tok + 1) * 160 + 128 + v4), vc); unpack4(*(const LAS u32x2*)(raw1 + tok * 160 + 128 + v4), vp);
          f32x4 o_v;
#pragma unroll
          for (int q = 0; q < 4; ++q) o_v[q] = vc[q] + muv[q] * (vp[q] - vc[q]);
          *(LAS f32x4*)(sv + tok * 32 + v4) = o_v; }
        __syncthreads();
        if (c + 1 < 64) R7_LOAD(c + 1)
#pragma unroll 4
        for (int s = 0; s < 64; ++s) {
            const f32x4 r4 = *(const LAS f32x4*)(sr + s * 64 + j0), k4 = *(const LAS f32x4*)(skp + s * 64 + j0), n4 = *(const LAS f32x4*)(snk + s * 64 + j0),
                        b4 = *(const LAS f32x4*)(sbb + s * 64 + j0), w4 = *(const LAS f32x4*)(sw + s * 64 + j0);
            const float v = sv[s * 32 + wid * 4 + quad];
            float sa = (S[0] * n4[0] + S[1] * n4[1]) + (S[2] * n4[2] + S[3] * n4[3]);
            sa = rowsum16(sa);
            S[0] = S[0] * w4[0] + sa * b4[0] + v * k4[0]; S[1] = S[1] * w4[1] + sa * b4[1] + v * k4[1]; S[2] = S[2] * w4[2] + sa * b4[2] + v * k4[2]; S[3] = S[3] * w4[3] + sa * b4[3] + v * k4[3];
            float y = (S[0] * r4[0] + S[1] * r4[1]) + (S[2] * r4[2] + S[3] * r4[3]);
            y = rowsum16(y);
            if (il == 0) sout[s * 32 + wid * 4 + quad] = f2bf(y);
        }
        __syncthreads();
        if (tid < 256) { const int s = tid >> 2, pc = tid & 3; *(u32x4*)(EXT + (size_t)(t0 + s) * 512 + hh * 64 + half * 32 + pc * 8) = *(const LAS u32x4*)(sout + s * 32 + pc * 8); }
    }
#undef R7_LOAD
    __syncthreads();
}

__device__ __forceinline__ void ph_odd_post(const Params& P, int j, int tid) {
    const int lane = tid & 63, gw = blockIdx.x * 8 + (tid >> 6), NGW = gridDim.x * 8;
    const bf16_t* Z = (const bf16_t*)(P.ws + OFF_Z); const bf16_t* HB = (const bf16_t*)(P.ws + OFF_HB); const bf16_t* EXT = (const bf16_t*)(P.ws + OFF_EXT); bf16_t* MIX = (bf16_t*)(P.ws + OFF_MIX);
    const int c0 = lane * 8;
    float nw[8], lnw[8], lnb[8], mur[8], muk[8], muv[8], kaw[8], rk[8], a0v[8];
#pragma unroll
    for (int q = 0; q < 8; ++q) { nw[q] = P.in[lsg(21)][j * 512 + c0 + q]; lnw[q] = P.in[lsg(31)][j * 512 + c0 + q]; lnb[q] = P.in[lsg(32)][j * 512 + c0 + q];
        mur[q] = P.in[lsg(22)][(size_t)j * 1792 + c0 + q]; muk[q] = P.in[lsg(22)][(size_t)j * 1792 + 512 + c0 + q]; muv[q] = P.in[lsg(22)][(size_t)j * 1792 + 1024 + c0 + q];
        kaw[q] = P.in[lsg(29)][j * 512 + c0 + q]; rk[q] = P.in[lsg(30)][j * 512 + c0 + q]; a0v[q] = P.in[lsg(25)][j * 512 + c0 + q]; }
    for (int t = gw; t < T; t += NGW) {
        const size_t zr = (size_t)t * ODN; bf16_t* mp = MIX + (size_t)t * 1024;
        { float o[8], g[8]; unpack8(*(const u32x4*)(mp + c0), o); unpack8(*(const u32x4*)(Z + zr + 1536 + c0), g);
          float ss = 0.f;
#pragma unroll
          for (int q = 0; q < 8; ++q) ss += o[q] * o[q];
          ss = wave_sum(ss); const float rs = rsqrtf(ss * (1.0f / 512.0f) + 1e-6f);
#pragma unroll
          for (int q = 0; q < 8; ++q) o[q] = o[q] * rs * nw[q] * sigmoidf_(g[q]);
          *(u32x4*)(mp + c0) = pack8(o); }
        { float y[8], rc[8], kc[8], vc[8], rp[8], kp[8], vp[8], av[8], gt[8];
          unpack8(*(const u32x4*)(EXT + (size_t)t * 512 + c0), y);
          unpack8(*(const u32x4*)(Z + zr + 2048 + c0), rc); unpack8(*(const u32x4*)(Z + zr + 2560 + c0), kc); unpack8(*(const u32x4*)(Z + zr + 3072 + c0), vc);
          if ((t & (SEQ - 1)) != 0) { unpack8(*(const u32x4*)(Z + zr - ODN + 2048 + c0), rp); unpack8(*(const u32x4*)(Z + zr - ODN + 2560 + c0), kp); unpack8(*(const u32x4*)(Z + zr - ODN + 3072 + c0), vp); }
          else {
#pragma unroll
              for (int q = 0; q < 8; ++q) { rp[q] = 0.f; kp[q] = 0.f; vp[q] = 0.f; } }
          unpack8(*(const u32x4*)(HB + (size_t)t * 1024 + 512 + c0), av); unpack8(*(const u32x4*)(mp + 512 + c0), gt);
          float sy = 0.f, dot = 0.f;
#pragma unroll
          for (int q = 0; q < 8; ++q) { av[q] = sigmoidf_(av[q] + a0v[q]); sy += y[q]; const float r = rc[q] + mur[q] * (rp[q] - rc[q]); const float k = kc[q] + muk[q] * (kp[q] - kc[q]); vc[q] = vc[q] + muv[q] * (vp[q] - vc[q]);
              dot += r * (k * (1.0f + (av[q] - 1.0f) * kaw[q])) * rk[q]; }
          sy = rowsum8(sy); dot = rowsum8(dot); const float mean = sy * (1.0f / 64.0f);
          float sv2 = 0.f;
#pragma unroll
          for (int q = 0; q < 8; ++q) { y[q] -= mean; sv2 += y[q] * y[q]; }
          sv2 = rowsum8(sv2); const float rstd = rsqrtf(sv2 * (1.0f / 64.0f) + 64e-5f);
          float o[8];
#pragma unroll
          for (int q = 0; q < 8; ++q) o[q] = (y[q] * rstd * lnw[q] + lnb[q] + dot * vc[q]) * gt[q];
          *(u32x4*)(mp + 512 + c0) = pack8(o); }
    }
}

__device__ __forceinline__ unsigned char* lws(unsigned char* p) { asm volatile("" : "+s"(p)); return p; }
__device__ __forceinline__ int ltid() { int t = threadIdx.x; asm volatile("" : "+v"(t)); return t; }
template <class Epi>
__device__ __forceinline__ void run_gemm(LAS unsigned char* lds, const bf16_t* A, const bf16_t* Bt, int N, int K, const Epi& E) {
    pg8::Gemm g; g.A = A; g.Bt = Bt; g.M = T; g.N = N; g.K = K;
    pg8::StaticOrder so; so.init(T, N, (int)gridDim.x, (int)blockIdx.x);
    pg8::gemm_phase<Epi, pg8::StaticOrder, false>(lds, g, so, E, nullptr);
}

__global__ void __launch_bounds__(512, 2) trunk_fwd(Params P) {
    extern __shared__ __attribute__((aligned(16))) unsigned char smem[];
    LAS unsigned char* lds = (LAS unsigned char*)smem;
    cg::grid_group grid = cg::this_grid();
#define ws lws(P.ws)
#define Zb ((bf16_t*)(ws + OFF_Z))
#define HB ((bf16_t*)(ws + OFF_HB))
#define MIX ((bf16_t*)(ws + OFF_MIX))
#define ACT ((bf16_t*)(ws + OFF_ACT))
#define UP ((bf16_t*)(ws + OFF_UP))
#define PB ((bf16_t*)(ws + OFF_PB))
#define LAo ((bf16_t*)(ws + OFF_LA))
#define ssA ((float*)(ws + OFF_SS))
#define ssB ((float*)(ws + OFF_SS) + 16 * T)
#define ssC ((float*)(ws + OFF_SS) + 32 * T)

    ph_convert(P, 0, lds, ltid());
    ph_prologue(P, ltid());
    grid.sync();

#pragma unroll 1
    for (int L = 0; L < 4; ++L) {
        const int j = L >> 1; const bool odd = (L & 1) != 0;
#define j lsg(L >> 1)
#define Wb ((const bf16_t*)(ws + OFF_W) + (odd ? WO_BASE : 0))
#define hin ((L == 0) ? HB : MIX)
        if (!odd) { EpiZ e; e.Z = Zb; e.ldc = EVN; e.ss = ssA; run_gemm(lds, hin, Wb + WE_IN, EVN, 1024, e); }
        else      { EpiZ e; e.Z = Zb; e.ldc = ODN; e.ss = ssA; run_gemm(lds, hin, Wb + WO_IN, ODN, 1024, e); }
        grid.sync();
#ifndef NO_EVEN
        if (!odd) {
            if (L + 1 < 4) ph_convert(P, L + 1, lds, ltid());
            ph_convert_p(P, L, ltid());
            __syncthreads();
            ph_rg_prep(P, j, lds, ltid());
            grid.sync();
            for (int task = blockIdx.x; task < 256; task += gridDim.x) { if (task < 128) ph_gdn(P, j, task, lds, ltid()); else ph_rg_scan(P, task - 128, lds, ltid()); }
            grid.sync();
            ph_gdn_post(P, j, ltid());
            grid.sync();
        }
#endif
#ifndef NO_ODD
        if (odd) {
            if (L + 1 < 4) ph_convert(P, L + 1, lds, ltid());
            ph_convert_p(P, L, ltid());
            ph_lora_prep(P, j, ltid());
            grid.sync();
            { EpiLora e; e.HBp = HB; e.MIXp = MIX; run_gemm(lds, LAo, Wb + WO_LORA, 1536, 256, e); }
            grid.sync();
            for (int task = blockIdx.x; task < 256; task += gridDim.x) { if (task < 128) ph_hgrn(P, j, task, lds, ltid()); else ph_rwkv(P, j, task - 128, lds, ltid()); }
            grid.sync();
            ph_odd_post(P, j, ltid());
            grid.sync();
        }
#endif
        { EpiRes e; e.H = P.out; e.HBp = HB; e.ssn = ssB; run_gemm(lds, MIX, Wb + (odd ? WO_OUT : WE_OUT), 1024, 1024, e); }
        grid.sync();
        { EpiGU e; e.ACTp = ACT; e.ss = ssB; run_gemm(lds, HB, Wb + (odd ? WO_GU : WE_GU), 5632, 1024, e); }
        { EpiUp e; e.O = UP; run_gemm(lds, PB, Wb + (odd ? WO_PU : WE_PU), 1024, 256, e); }
        grid.sync();
        { EpiRes e; e.H = P.out; e.HBp = HB; e.ssn = ssC; run_gemm(lds, ACT, Wb + (odd ? WO_DN : WE_DN), 1024, 2816, e); }
        grid.sync();
        { EpiPle e; e.H = P.out; e.HBp = MIX; e.ssn = ssA; e.ss = ssC; e.UPp = UP; run_gemm(lds, HB, Wb + (odd ? WO_PG : WE_PG), 1024, 1024, e); }
        grid.sync();
    }
#undef j
#undef Wb
#undef hin
    ph_final(P, ltid());
}

#undef ws
#undef Zb
#undef HB
#undef MIX
#undef ACT
#undef UP
#undef PB
#undef LAo
#undef ssA
#undef ssB
#undef ssC
extern "C" void kernel_launch(void* const* d_in, const int* in_sizes, int n_in, void* d_out, int out_size, void* d_ws, size_t ws_size, hipStream_t stream) {
    static int grid_blocks = 0;
    if (grid_blocks == 0) {
        if (n_in != 39 || out_size != T * DM || ws_size < WS_END) { fprintf(stderr, "kernel_launch: unexpected shapes: n_in %d out %d ws %zu (need %zu)\n", n_in, out_size, ws_size, (size_t)WS_END); grid_blocks = -1; return; }
        int dev = 0, cus = 0, per_cu = 0;
        hipGetDevice(&dev);
        hipDeviceGetAttribute(&cus, hipDeviceAttributeMultiprocessorCount, dev);
        if (hipFuncSetAttribute((const void*)trunk_fwd, hipFuncAttributeMaxDynamicSharedMemorySize, LDS_BYTES) != hipSuccess) { fprintf(stderr, "kernel_launch: hipFuncSetAttribute failed\n"); grid_blocks = -1; return; }
        if (hipOccupancyMaxActiveBlocksPerMultiprocessor(&per_cu, (const void*)trunk_fwd, 512, LDS_BYTES) != hipSuccess || per_cu < 1) { fprintf(stderr, "kernel_launch: occupancy query says %d\n", per_cu); per_cu = 1; }
        (void)hipGetLastError();
        grid_blocks = cus;
        fprintf(stderr, "kernel_launch: grid %d (per_cu %d), ws %zu need %zu\n", grid_blocks, per_cu, ws_size, (size_t)WS_END);
    }
    if (grid_blocks < 0) return;
    Params p{};
    for (int i = 0; i < 39; ++i) p.in[i] = (const float*)d_in[i];
    p.out = (float*)d_out; p.ws = (unsigned char*)d_ws;
    void* args[] = {&p};
    hipError_t e = hipLaunchCooperativeKernel((const void*)trunk_fwd, dim3(grid_blocks), dim3(512), args, LDS_BYTES, stream);
    if (e != hipSuccess) fprintf(stderr, "cooperative launch failed: %s (grid %d)\n", hipGetErrorString(e), grid_blocks);
}
```

```cpp
#include <hip/hip_runtime.h>
#include <hip/hip_cooperative_groups.h>
#include <cstdio>
#include <cstdint>
namespace cg = cooperative_groups;
namespace pg8 {
#define PG8_LAS __attribute__((address_space(3)))
typedef unsigned short bf16_t;
typedef short bf16x8 __attribute__((ext_vector_type(8)));
typedef float f32x4 __attribute__((ext_vector_type(4)));
typedef unsigned u32x4 __attribute__((ext_vector_type(4)));
constexpr int BM = 256, BK = 64, HALF = 128, HTB = HALF * BK * 2  , STAGE_BYTES = 8 * HTB, NXCD = 8, WGM = 8;

__host__ __device__ __forceinline__ int lds_byte(int r, int c) { const int st = (r >> 4) * 2 + (c >> 5), rr = r & 15, cc = c & 31, ob = rr * 64 + cc * 2; return st * 1024 + (ob ^ (((ob >> 9) & 1) << 5)); }
__host__ __device__ __forceinline__ void stage_rc(int b, int& R, int& C) { const int st = b / 1024, sb = b % 1024, swz = sb ^ (((sb >> 9) & 1) << 5); R = (st >> 1) * 16 + swz / 64; C = (st & 1) * 32 + (swz % 64) / 2; }
__host__ __device__ __forceinline__ int perm32(int rho) { const int n = rho >> 4, i = rho & 15; return 8 * (i >> 2) + 4 * n + (i & 3); }

struct Unit { int pm, pn; };
struct Gemm { const bf16_t* A; const bf16_t* Bt; int M, N, K; };

struct StaticOrder {
    int nM, nN, nwg, G, c;
    __host__ __device__ void init(int M, int N, int G_, int c_) { nM = M / BM; nN = N / BM; nwg = nM * nN; G = G_; c = c_; }
    __host__ __device__ bool next(int i, Unit& u) const {
        const long L = (long)i * G + c; if (L >= nwg) return false;
        int wgid = (int)L; { const int q = nwg / NXCD, r = nwg % NXCD, xcd = wgid % NXCD, off = wgid / NXCD; wgid = (xcd < r ? xcd * (q + 1) : r * (q + 1) + (xcd - r) * q) + off; }
        const int nig = WGM * nN, gid = wgid / nig, fm = gid * WGM, gsz = (nM - fm) < WGM ? (nM - fm) : WGM;
        u.pm = fm + ((wgid % nig) % gsz); u.pn = (wgid % nig) / gsz; return true;
    }
    __device__ __forceinline__ void a_ready(const Unit&) const {}
    __device__ __forceinline__ void done(const Unit&) const {}
};
}
namespace pg8 {
__device__ __forceinline__ unsigned cvt_pk_bf16(float lo, float hi) { unsigned r; asm volatile("v_cvt_pk_bf16_f32 %0, %1, %2" : "=v"(r) : "v"(lo), "v"(hi)); return r; }
typedef float f32x2 __attribute__((ext_vector_type(2)));
template <class Epi, class Sched, bool STAMP = false>
__device__ __forceinline__ void gemm_phase(PG8_LAS unsigned char* lds, const Gemm g, const Sched& S, const Epi& E, unsigned long long* stamps) {
    int tid_l = threadIdx.x; asm volatile("" : "+v"(tid_l));
    const int tid = tid_l, wid = __builtin_amdgcn_readfirstlane(tid >> 6), lane = tid & 63, wr = wid >> 2, wc = wid & 3, fr = lane & 15, fq = lane >> 4;
    const int K = g.K, nt = K / BK;
    int ts_lo = 0, ts_hi = 0, nts = 0; const unsigned long long rt_entry = STAMP ? (unsigned long long)wall_clock64() : 0ull;
#define PG8_STAMP() do { if (STAMP && wid == 0 && nts < 64) { const unsigned long long _c = (unsigned long long)clock64(); \
        ts_lo = (lane == nts) ? (int)(unsigned)_c : ts_lo; ts_hi = (lane == nts) ? (int)(unsigned)(_c >> 32) : ts_hi; ++nts; } } while (0)
    PG8_STAMP();
    unsigned voffA[2], voffB[2];
#pragma unroll
    for (int i = 0; i < 2; ++i) { int R, C; stage_rc(tid * 16 + i * 8192, R, C); const int Rb = Epi::PERM ? ((R & ~31) + perm32(R & 31)) : R;
        voffA[i] = (unsigned)(R * K + C) * 2u; voffB[i] = (unsigned)(Rb * K + C) * 2u; }
    const size_t kstep = (size_t)(BK * 2);
    const size_t hstep = (size_t)HALF * K * 2;
    const size_t tstep = 2 * hstep;
    const unsigned ldsw = (unsigned)wid * 1024u;
    const int aoff = lds_byte(wr * 64 + fr, fq * 8), boff = lds_byte(wc * 32 + fr, fq * 8);
#define PG8_SA(b, h) (((b) * 2 + (h)) * HTB)
#define PG8_SB(b, h) ((4 + (b) * 2 + (h)) * HTB)
#define PG8_STAGE(bufoff, gbase, voff) do { _Pragma("unroll") for (int _i = 0; _i < 2; ++_i) \
        __builtin_amdgcn_global_load_lds((const unsigned*)((const char*)(gbase) + (voff)[_i]), (PG8_LAS unsigned*)(lds + (bufoff) + ldsw + _i * 8192), 16, 0, 0); } while (0)
#define PG8_LDA(dst, b, h) do { _Pragma("unroll") for (int m = 0; m < 4; ++m) _Pragma("unroll") for (int k = 0; k < 2; ++k) dst[m][k] = *(const PG8_LAS bf16x8*)(lds + PG8_SA(b, h) + aoff + m * 2048 + k * 1024); } while (0)
#define PG8_LDB(dst, b, h) do { _Pragma("unroll") for (int n = 0; n < 2; ++n) _Pragma("unroll") for (int k = 0; k < 2; ++k) dst[n][k] = *(const PG8_LAS bf16x8*)(lds + PG8_SB(b, h) + boff + n * 2048 + k * 1024); } while (0)
#define PG8_MMA(ai, bj, At, Bt) do { __builtin_amdgcn_s_setprio(1); _Pragma("unroll") for (int m = 0; m < 4; ++m) _Pragma("unroll") for (int n = 0; n < 2; ++n) _Pragma("unroll") for (int k = 0; k < 2; ++k) \
        acc[ai][bj][m][n] = __builtin_amdgcn_mfma_f32_16x16x32_bf16(Bt[n][k], At[m][k], acc[ai][bj][m][n], 0, 0, 0); __builtin_amdgcn_s_setprio(0); } while (0)
#define PG8_WAIT_V(n) asm volatile("s_waitcnt vmcnt(" #n ")" ::: "memory")
#define PG8_WAIT_L(n) asm volatile("s_waitcnt lgkmcnt(" #n ")" ::: "memory")
#define PG8_BAR __builtin_amdgcn_s_barrier()
#define PG8_SCHED __builtin_amdgcn_sched_barrier(0)
    Unit cur, nxt; int ui = 0;
    if (!S.next(0, cur)) return;
    f32x4 acc[2][2][4][2];
#pragma unroll
    for (int a = 0; a < 2; ++a)
#pragma unroll
        for (int b = 0; b < 2; ++b)
#pragma unroll
            for (int m = 0; m < 4; ++m)
#pragma unroll
                for (int n = 0; n < 2; ++n) acc[a][b][m][n] = (f32x4){0.f, 0.f, 0.f, 0.f};
    bf16x8 At[4][2], B0[2][2], B1[2][2];
    const char* cA = (const char*)g.A + (size_t)cur.pm * tstep; const char* cB = (const char*)g.Bt + (size_t)cur.pn * tstep;
    S.a_ready(cur);
    PG8_STAGE(PG8_SB(0, 0), cB, voffB); PG8_STAGE(PG8_SA(0, 0), cA, voffA); PG8_STAGE(PG8_SB(0, 1), cB + hstep, voffB); PG8_STAGE(PG8_SA(0, 1), cA + hstep, voffA);
    if (wr == 1) PG8_BAR;
    PG8_WAIT_V(4); PG8_BAR;
    PG8_STAGE(PG8_SB(1, 0), cB + kstep, voffB); PG8_STAGE(PG8_SA(1, 0), cA + kstep, voffA); PG8_STAGE(PG8_SB(1, 1), cB + hstep + kstep, voffB);
    PG8_WAIT_V(6); PG8_BAR;
    PG8_STAMP();
    for (;;) {
        const bool has_next = S.next(ui + 1, nxt);
        const char* nA = has_next ? (const char*)g.A + (size_t)nxt.pm * tstep : cA; const char* nB = has_next ? (const char*)g.Bt + (size_t)nxt.pn * tstep : cB;
        for (int t = 0; t < nt; t += 2) {
            const bool last = (t == nt - 2);
            const char* a1 = cA + (size_t)(t + 1) * kstep;
            const char* a2 = last ? nA : cA + (size_t)(t + 2) * kstep; const char* b2 = last ? nB : cB + (size_t)(t + 2) * kstep;
            const char* a3 = a2 + kstep; const char* b3 = b2 + kstep;
            if (last && has_next) S.a_ready(nxt);
            PG8_LDB(B0, 0, 0); PG8_SCHED; PG8_LDA(At, 0, 0); PG8_STAGE(PG8_SA(1, 1), a1 + hstep, voffA);
            PG8_WAIT_L(8); PG8_BAR; PG8_WAIT_L(0); PG8_MMA(0, 0, At, B0); PG8_BAR; PG8_SCHED;
            PG8_LDB(B1, 0, 1); PG8_STAGE(PG8_SB(0, 0), b2, voffB);
            PG8_BAR; PG8_WAIT_L(0); PG8_MMA(0, 1, At, B1); PG8_BAR;
            PG8_LDA(At, 0, 1); PG8_STAGE(PG8_SA(0, 0), a2, voffA);
            PG8_BAR; PG8_WAIT_L(0); PG8_MMA(1, 0, At, B0); PG8_BAR; PG8_SCHED;
            PG8_STAGE(PG8_SB(0, 1), b2 + hstep, voffB);
            PG8_WAIT_V(6); PG8_BAR; PG8_MMA(1, 1, At, B1); PG8_BAR;
            PG8_LDB(B0, 1, 0); PG8_SCHED; PG8_LDA(At, 1, 0); PG8_STAGE(PG8_SA(0, 1), a2 + hstep, voffA);
            PG8_WAIT_L(8); PG8_BAR; PG8_WAIT_L(0); PG8_MMA(0, 0, At, B0); PG8_BAR; PG8_SCHED;
            PG8_LDB(B1, 1, 1); PG8_STAGE(PG8_SB(1, 0), b3, voffB);
            PG8_BAR; PG8_WAIT_L(0); PG8_MMA(0, 1, At, B1); PG8_BAR;
            PG8_LDA(At, 1, 1); PG8_STAGE(PG8_SA(1, 0), a3, voffA);
            PG8_BAR; PG8_WAIT_L(0); PG8_MMA(1, 0, At, B0); PG8_BAR; PG8_SCHED;
            PG8_STAGE(PG8_SB(1, 1), b3 + hstep, voffB);
            PG8_WAIT_V(6); PG8_BAR; PG8_MMA(1, 1, At, B1); PG8_BAR;
        }
        PG8_STAMP();
        if constexpr (!Epi::AFTER_DRAIN) { E(acc, cur, wr, wc, fr, fq); S.done(cur); }
        PG8_STAMP();
        if (!has_next) break;
#pragma unroll
        for (int a = 0; a < 2; ++a)
#pragma unroll
            for (int b = 0; b < 2; ++b)
#pragma unroll
                for (int m = 0; m < 4; ++m)
#pragma unroll
                    for (int n = 0; n < 2; ++n) acc[a][b][m][n] = (f32x4){0.f, 0.f, 0.f, 0.f};
        cur = nxt; cA = nA; cB = nB; ++ui;
    }
    PG8_WAIT_V(0);
    if (wr == 0) PG8_BAR;
    PG8_BAR;
    if constexpr (Epi::AFTER_DRAIN) { E.fused(acc, cur, wr, wc, fr, fq, lds, wid, lane); S.done(cur); }
    PG8_STAMP();
    if (STAMP && wid == 0) { stamps[lane] = lane < nts ? (((unsigned long long)(unsigned)ts_hi << 32) | (unsigned)ts_lo) : 0ull;
        if (lane == 62) stamps[62] = rt_entry; if (lane == 63) stamps[63] = (unsigned long long)wall_clock64(); }
#undef PG8_STAMP
#undef PG8_SA
#undef PG8_SB
#undef PG8_STAGE
#undef PG8_LDA
#undef PG8_LDB
#undef PG8_MMA
#undef PG8_WAIT_V
#undef PG8_WAIT_L
#undef PG8_BAR
#undef PG8_SCHED
}
}

using pg8::bf16_t; using pg8::f32x4; using pg8::u32x4; using pg8::bf16x8; using pg8::Unit; using pg8::cvt_pk_bf16;
typedef unsigned u32x2 __attribute__((ext_vector_type(2)));
typedef float f32x2 __attribute__((ext_vector_type(2)));
#define LAS __attribute__((address_space(3)))

constexpr int T = 32768, DM = 1024, FF = 2816, SEQ = 4096;
constexpr int EVN = 3328, ODN = 3840;
constexpr int LDS_BYTES = 147456;
constexpr size_t WE_IN = 0, WE_OUT = WE_IN + (size_t)3328 * 1024, WE_GU = WE_OUT + (size_t)1024 * 1024, WE_DN = WE_GU + (size_t)5632 * 1024,
                 WE_PG = WE_DN + (size_t)1024 * 2816, WE_PU = WE_PG + (size_t)1024 * 1024, WE_END = WE_PU + (size_t)1024 * 256;
constexpr size_t WO_BASE = WE_END;
constexpr size_t WO_IN = 0, WO_LORA = WO_IN + (size_t)3840 * 1024, WO_OUT = WO_LORA + (size_t)1536 * 256, WO_GU = WO_OUT + (size_t)1024 * 1024,
                 WO_DN = WO_GU + (size_t)5632 * 1024, WO_PG = WO_DN + (size_t)1024 * 2816, WO_PU = WO_PG + (size_t)1024 * 1024, WO_END = WO_PU + (size_t)1024 * 256;
constexpr size_t OFF_W = 0;
constexpr size_t OFF_Z = (WE_END + WO_END) * 2;
constexpr size_t OFF_HB = OFF_Z + (size_t)T * 3840 * 2;
constexpr size_t OFF_MIX = OFF_HB + (size_t)T * 1024 * 2;
constexpr size_t OFF_PB = OFF_MIX + (size_t)T * 1024 * 2;
constexpr size_t OFF_LA = OFF_PB + (size_t)T * 256 * 2;
constexpr size_t OFF_EXT = OFF_LA + (size_t)T * 256 * 2;
constexpr size_t OFF_SS = OFF_EXT + (size_t)T * 512 * 2;
constexpr size_t OFF_BAR = OFF_SS + (size_t)3 * T * 16 * 4;
constexpr size_t WS_END = OFF_BAR + 16384;
constexpr size_t OFF_QK = OFF_MIX;
constexpr size_t OFF_ACT = OFF_Z, OFF_UP = OFF_Z + (size_t)T * 2816 * 2;

struct Params { const float* in[39]; float* out; unsigned char* ws; };

__device__ __forceinline__ int lsg(int k) { asm volatile("" : "+s"(k)); return k; }
extern __shared__ __attribute__((aligned(16))) unsigned char smem_g[];
constexpr int TAB_OFF = LDS_BYTES - 512;
constexpr int RS_OFF = 131072;
__device__ __forceinline__ const float* tabptr(int k) { int off = TAB_OFF + 8 * k; asm volatile("" : "+v"(off));
    const LAS unsigned* t = (const LAS unsigned*)((LAS unsigned char*)smem_g + off); unsigned lo = t[0], hi = t[1];
    lo = __builtin_amdgcn_readfirstlane(lo); hi = __builtin_amdgcn_readfirstlane(hi); return (const float*)(const __attribute__((address_space(1))) float*)(((uintptr_t)hi << 32) | (uintptr_t)lo); }
#define PIN(k) tabptr(k)
#define PWS() ((unsigned char*)tabptr(39))
#define POUT() ((float*)tabptr(40))
__device__ __forceinline__ float bflo(unsigned w) { return __uint_as_float(w << 16); }
__device__ __forceinline__ float bfhi(unsigned w) { return __uint_as_float(w & 0xffff0000u); }
__device__ __forceinline__ float bf2f(bf16_t u) { return __uint_as_float(((unsigned)u) << 16); }
__device__ __forceinline__ bf16_t f2bf(float f) { return (bf16_t)(cvt_pk_bf16(f, 0.f) & 0xffffu); }
__device__ __forceinline__ void unpack8(const u32x4 w, float (&f)[8]) { f[0] = bflo(w.x); f[1] = bfhi(w.x); f[2] = bflo(w.y); f[3] = bfhi(w.y); f[4] = bflo(w.z); f[5] = bfhi(w.z); f[6] = bflo(w.w); f[7] = bfhi(w.w); }
__device__ __forceinline__ u32x4 pack8(const float (&f)[8]) { u32x4 w; w.x = cvt_pk_bf16(f[0], f[1]); w.y = cvt_pk_bf16(f[2], f[3]); w.z = cvt_pk_bf16(f[4], f[5]); w.w = cvt_pk_bf16(f[6], f[7]); return w; }
__device__ __forceinline__ void unpack4(const u32x2 w, float (&f)[4]) { f[0] = bflo(w.x); f[1] = bfhi(w.x); f[2] = bflo(w.y); f[3] = bfhi(w.y); }
__device__ __forceinline__ float sigmoidf_(float x) { return __builtin_amdgcn_rcpf(1.0f + __expf(-x)); }
__device__ __forceinline__ float siluf_(float x) { return x * __builtin_amdgcn_rcpf(1.0f + __expf(-x)); }
__device__ __forceinline__ float softplusf_(float x) { return fmaxf(x, 0.f) + log1pf(__expf(-fabsf(x))); }
__device__ __forceinline__ float gelu_tanh(float x) { const float y = 0.7978845608028654f * (x + 0.044715f * x * x * x); const float t = 1.0f - 2.0f * __builtin_amdgcn_rcpf(1.0f + __expf(2.0f * y)); return 0.5f * x * (1.0f + t); }
template <int CTRL> __device__ __forceinline__ float dppf(float v) { return __int_as_float(__builtin_amdgcn_update_dpp(0, __float_as_int(v), CTRL, 0xF, 0xF, true)); }
__device__ __forceinline__ float rowsum16(float v) { v += dppf<0xB1>(v); v += dppf<0x4E>(v); v += dppf<0x141>(v); v += dppf<0x140>(v); return v; }
__device__ __forceinline__ float rowsum8(float v) { v += dppf<0xB1>(v); v += dppf<0x4E>(v); v += dppf<0x141>(v); return v; }
__device__ __forceinline__ float wave_sum(float v) {
    v = rowsum16(v);
    const float a = __int_as_float(__builtin_amdgcn_readlane(__float_as_int(v), 0)), b = __int_as_float(__builtin_amdgcn_readlane(__float_as_int(v), 16)),
                c = __int_as_float(__builtin_amdgcn_readlane(__float_as_int(v), 32)), d = __int_as_float(__builtin_amdgcn_readlane(__float_as_int(v), 48));
    return (a + b) + (c + d);
}
__device__ __forceinline__ float quadsum(float s, int lane) {
    s += __int_as_float(__builtin_amdgcn_ds_bpermute((lane ^ 16) << 2, __float_as_int(s)));
    s += __int_as_float(__builtin_amdgcn_ds_bpermute((lane ^ 32) << 2, __float_as_int(s)));
    return s;
}
__device__ __forceinline__ u32x4 zero_u4() { unsigned z = 0u; asm volatile("" : "+v"(z)); u32x4 r = {z, z, z, z}; return r; }
__device__ __forceinline__ float rowss(const float* ss, int row) {
    const f32x4* p = (const f32x4*)(ss + (size_t)row * 16); const f32x4 a = p[0], b = p[1], c = p[2], d = p[3];
    return (((a[0] + a[1]) + (a[2] + a[3])) + ((b[0] + b[1]) + (b[2] + b[3]))) + (((c[0] + c[1]) + (c[2] + c[3])) + ((d[0] + d[1]) + (d[2] + d[3])));
}
#define LDS_FENCE() asm volatile("s_waitcnt lgkmcnt(0)" ::: "memory")

#define XB_TMO      128
#define XB_XCNT(j)  (256  + 64 * (j))
#define XB_XSUB(j)  (1280 + 64 * (j))
#define XB_XGEN(j)  (2304 + 64 * (j))
#define XB_TOP      3328
#define XB_TOPGEN   3392
#define XCD_BAR_WORDS 3456
#define XB_SPIN_CAP (1u << 22)

__device__ __forceinline__ unsigned xb_ld(unsigned* p)              { return __hip_atomic_load(p, __ATOMIC_RELAXED, __HIP_MEMORY_SCOPE_AGENT); }
__device__ __forceinline__ unsigned xb_add(unsigned* p, unsigned v) { return __hip_atomic_fetch_add(p, v, __ATOMIC_RELAXED, __HIP_MEMORY_SCOPE_AGENT); }
__device__ __forceinline__ unsigned xb_xcc_id() { return (unsigned)__builtin_amdgcn_s_getreg((3 << 11) | 20) & 0xFu; }
#define XB_SPIN(cond, bar) do { unsigned _sp = 0; while (cond) { __builtin_amdgcn_s_sleep(1); \
    if ((++_sp & 255u) == 0u) { if (xb_ld(&(bar)[XB_TMO])) break; if (_sp > XB_SPIN_CAP) { atomicAdd(&(bar)[XB_TMO], 1u); break; } } } } while (0)

struct XcdBarrier {
    unsigned* bar; unsigned x;
    volatile LAS unsigned* st;
};

__device__ __forceinline__ XcdBarrier xcd_barrier_post(unsigned* bar, volatile LAS unsigned* st) {
    XcdBarrier b; b.bar = bar; b.x = xb_xcc_id(); b.st = st;
    if (threadIdx.x == 0) (void)xb_add(&bar[XB_XCNT(b.x)], 1u);
    return b;
}
__device__ __forceinline__ void xcd_barrier_complete(unsigned* bar, unsigned x, unsigned& nloc, unsigned& nx) {
    const unsigned G = gridDim.x * gridDim.y * gridDim.z;
    unsigned sum, cnt, mine, sp = 0u;
    for (;;) {
        sum = 0u; cnt = 0u; mine = 0u;
#pragma unroll
        for (unsigned j = 0; j < 16; ++j) { const unsigned c = xb_ld(&bar[XB_XCNT(j)]); sum += c; cnt += (c > 0u) ? 1u : 0u; mine = (j == x) ? c : mine; }
        if (sum == G) break;
        __builtin_amdgcn_s_sleep(1);
        if ((++sp & 255u) == 0u) { if (xb_ld(&bar[XB_TMO])) break; if (sp > XB_SPIN_CAP) { atomicAdd(&bar[XB_TMO], 1u); break; } }
    }
    nloc = mine > 0u ? mine : 1u; nx = cnt > 0u ? cnt : 1u;
}

__device__ __forceinline__ void xcd_barrier(const XcdBarrier& b) {
    asm volatile("s_waitcnt vmcnt(0)" ::: "memory");
    __syncthreads();
    if (threadIdx.x == 0) {
        unsigned* bar = b.bar;
        __builtin_amdgcn_s_waitcnt(0);
        unsigned nloc = b.st[0], nx = b.st[1];
        if (nloc == 0u) { xcd_barrier_complete(bar, b.x, nloc, nx); b.st[0] = nloc; b.st[1] = nx; }
        const unsigned old = xb_add(&bar[XB_XSUB(b.x)], 1u);
        const unsigned gen = old / nloc;
        if (old + 1u == (gen + 1u) * nloc) {
            __builtin_amdgcn_fence(__ATOMIC_RELEASE, "agent");
            asm volatile("s_waitcnt vmcnt(0)" ::: "memory");
            const unsigned og = xb_add(&bar[XB_TOP], 1u);
            const unsigned tg = og / nx;
            if (og + 1u == (tg + 1u) * nx) xb_add(&bar[XB_TOPGEN], 1u);
            else XB_SPIN(xb_ld(&bar[XB_TOPGEN]) == tg, bar);
            __builtin_amdgcn_fence(__ATOMIC_ACQUIRE, "agent");
            xb_add(&bar[XB_XGEN(b.x)], 1u);
            asm volatile("s_waitcnt vmcnt(0)" ::: "memory");
        } else {
            XB_SPIN(xb_ld(&bar[XB_XGEN(b.x)]) == gen, bar);
            __builtin_amdgcn_fence(__ATOMIC_ACQUIRE, "agent");
            asm volatile("s_waitcnt vmcnt(0)" ::: "memory");
        }
    }
    __syncthreads();
}


__device__ __forceinline__ void st16_wt(void* p, const u32x4 v) { asm volatile("global_store_dwordx4 %0, %1, off sc1\n\ts_nop 1" :: "v"(p), "v"(v) : "memory"); }
struct EpiZ {
    static constexpr bool PERM = true, AFTER_DRAIN = false;
    bf16_t* Z; int ldc; const float* ss; mutable int ui = 0;
    __device__ __forceinline__ void operator()(const f32x4 (&acc)[2][2][4][2], const Unit& u, int wr, int wc, int fr, int fq) const {
        const LAS float* rst = (const LAS float*)((LAS unsigned char*)smem_g + RS_OFF) + ui * 256; ++ui;
        const int row0 = u.pm * 256 + wr * 64 + fr, col0 = u.pn * 256 + wc * 32 + 8 * fq;
#pragma unroll
        for (int ai = 0; ai < 2; ++ai)
#pragma unroll
            for (int m = 0; m < 4; ++m) {
                const int row = row0 + ai * 128 + m * 16; const float rs = rst[ai * 128 + wr * 64 + m * 16 + fr];
                bf16_t* rowp = Z + (size_t)row * ldc + col0;
#pragma unroll
                for (int bj = 0; bj < 2; ++bj) { const f32x4 v0 = acc[ai][bj][m][0] * rs, v1 = acc[ai][bj][m][1] * rs;
                    u32x4 w; w.x = cvt_pk_bf16(v0[0], v0[1]); w.y = cvt_pk_bf16(v0[2], v0[3]); w.z = cvt_pk_bf16(v1[0], v1[1]); w.w = cvt_pk_bf16(v1[2], v1[3]);
                    st16_wt(rowp + bj * 128, w); } }
    }
};
struct EpiRes {
    static constexpr bool PERM = true, AFTER_DRAIN = false;
    bf16_t* Hp; float* ssn;
    __device__ __forceinline__ void operator()(const f32x4 (&acc)[2][2][4][2], const Unit& u, int wr, int wc, int fr, int fq) const {
        const int row0 = u.pm * 256 + wr * 64 + fr, col0 = u.pn * 256 + wc * 32 + 8 * fq;
#pragma unroll
        for (int ai = 0; ai < 2; ++ai) {
            u32x4 hw[4][2];
#pragma unroll
            for (int m = 0; m < 4; ++m)
#pragma unroll
                for (int bj = 0; bj < 2; ++bj) hw[m][bj] = *(const u32x4*)(Hp + (size_t)(row0 + ai * 128 + m * 16) * 1024 + col0 + bj * 128);
#pragma unroll
            for (int m = 0; m < 4; ++m) {
                const int row = row0 + ai * 128 + m * 16; bf16_t* rowp = Hp + (size_t)row * 1024 + col0; float s = 0.f;
#pragma unroll
                for (int bj = 0; bj < 2; ++bj) { float hf[8]; unpack8(hw[m][bj], hf);
#pragma unroll
                    for (int n = 0; n < 2; ++n)
#pragma unroll
                        for (int q = 0; q < 4; ++q) { hf[n * 4 + q] += acc[ai][bj][m][n][q]; s += hf[n * 4 + q] * hf[n * 4 + q]; }
                    st16_wt(rowp + bj * 128, pack8(hf)); }
                s = quadsum(s, fq * 16 + fr);
                if (fq == 0) ssn[(size_t)row * 16 + u.pn * 4 + wc] = s; }
            asm volatile("" ::: "memory"); }
    }
};
struct EpiGU {
    static constexpr bool PERM = true, AFTER_DRAIN = false;
    bf16_t* ACTp; const float* ss; mutable int ui = 0;
    __device__ __forceinline__ void operator()(const f32x4 (&acc)[2][2][4][2], const Unit& u, int wr, int wc, int fr, int fq) const {
        const LAS float* rst = (const LAS float*)((LAS unsigned char*)smem_g + RS_OFF) + ui * 256; ++ui;
        const int row0 = u.pm * 256 + wr * 64 + fr, col0 = u.pn * 128 + wc * 32 + 8 * fq;
#pragma unroll
        for (int ai = 0; ai < 2; ++ai)
#pragma unroll
            for (int m = 0; m < 4; ++m) {
                const int row = row0 + ai * 128 + m * 16; const float rs = rst[ai * 128 + wr * 64 + m * 16 + fr];
                float o[8];
#pragma unroll
                for (int n = 0; n < 2; ++n)
#pragma unroll
                    for (int q = 0; q < 4; ++q) { const float g = acc[ai][0][m][n][q] * rs, up = acc[ai][1][m][n][q] * rs; o[n * 4 + q] = siluf_(g) * up; }
                st16_wt(ACTp + (size_t)row * FF + col0, pack8(o)); }
    }
};
struct EpiPle {
    static constexpr bool PERM = true, AFTER_DRAIN = false;
    const bf16_t* Hin; bf16_t* Hout; float* ssn; const float* ss; const bf16_t* UPp; mutable int ui = 0;
    __device__ __forceinline__ void operator()(const f32x4 (&acc)[2][2][4][2], const Unit& u, int wr, int wc, int fr, int fq) const {
        const LAS float* rst = (const LAS float*)((LAS unsigned char*)smem_g + RS_OFF) + ui * 256; ++ui;
        const int row0 = u.pm * 256 + wr * 64 + fr, col0 = u.pn * 256 + wc * 32 + 8 * fq;
#pragma unroll
        for (int ai = 0; ai < 2; ++ai) {
            u32x4 hw[4][2], uw[4][2];
#pragma unroll
            for (int m = 0; m < 4; ++m)
#pragma unroll
                for (int bj = 0; bj < 2; ++bj) { const size_t off = (size_t)(row0 + ai * 128 + m * 16) * 1024 + col0 + bj * 128; hw[m][bj] = *(const u32x4*)(Hin + off); uw[m][bj] = *(const u32x4*)(UPp + off); }
#pragma unroll
            for (int m = 0; m < 4; ++m) {
                const int row = row0 + ai * 128 + m * 16; const size_t off = (size_t)row * 1024 + col0; float s = 0.f;
                const float rs = rst[ai * 128 + wr * 64 + m * 16 + fr];
#pragma unroll
                for (int bj = 0; bj < 2; ++bj) { float hf[8], uf[8]; unpack8(hw[m][bj], hf); unpack8(uw[m][bj], uf);
#pragma unroll
                    for (int n = 0; n < 2; ++n)
#pragma unroll
                        for (int q = 0; q < 4; ++q) { hf[n * 4 + q] += sigmoidf_(acc[ai][bj][m][n][q] * rs) * uf[n * 4 + q]; s += hf[n * 4 + q] * hf[n * 4 + q]; }
                    st16_wt(Hout + off + bj * 128, pack8(hf)); }
                s = quadsum(s, fq * 16 + fr);
                if (fq == 0) ssn[(size_t)row * 16 + u.pn * 4 + wc] = s; }
            asm volatile("" ::: "memory"); }
    }
};
struct EpiUp {
    static constexpr bool PERM = true, AFTER_DRAIN = false;
    bf16_t* O;
    __device__ __forceinline__ void operator()(const f32x4 (&acc)[2][2][4][2], const Unit& u, int wr, int wc, int fr, int fq) const {
        const int row0 = u.pm * 256 + wr * 64 + fr, col0 = u.pn * 256 + wc * 32 + 8 * fq;
#pragma unroll
        for (int ai = 0; ai < 2; ++ai)
#pragma unroll
            for (int m = 0; m < 4; ++m) {
                bf16_t* rowp = O + (size_t)(row0 + ai * 128 + m * 16) * 1024 + col0;
#pragma unroll
                for (int bj = 0; bj < 2; ++bj) { const f32x4 v0 = acc[ai][bj][m][0], v1 = acc[ai][bj][m][1];
                    u32x4 w; w.x = cvt_pk_bf16(v0[0], v0[1]); w.y = cvt_pk_bf16(v0[2], v0[3]); w.z = cvt_pk_bf16(v1[0], v1[1]); w.w = cvt_pk_bf16(v1[2], v1[3]);
                    st16_wt(rowp + bj * 128, w); } }
    }
};
struct EpiLora {
    static constexpr bool PERM = true, AFTER_DRAIN = false;
    bf16_t* HBp; bf16_t* MIXp;
    __device__ __forceinline__ void operator()(const f32x4 (&acc)[2][2][4][2], const Unit& u, int wr, int wc, int fr, int fq) const {
        const int row0 = u.pm * 256 + wr * 64 + fr; const int kind = u.pn >> 1; const int cc0 = (u.pn & 1) * 256 + wc * 32 + 8 * fq;
        bf16_t* dbase = ((kind == 2) ? (MIXp + 512) : (HBp + (kind == 1 ? 512 : 0))) + cc0;
#pragma unroll
        for (int ai = 0; ai < 2; ++ai)
#pragma unroll
            for (int m = 0; m < 4; ++m) {
                bf16_t* rowp = dbase + (size_t)(row0 + ai * 128 + m * 16) * 1024;
#pragma unroll
                for (int bj = 0; bj < 2; ++bj) { const f32x4 v0 = acc[ai][bj][m][0], v1 = acc[ai][bj][m][1];
                    u32x4 w; w.x = cvt_pk_bf16(v0[0], v0[1]); w.y = cvt_pk_bf16(v0[2], v0[3]); w.z = cvt_pk_bf16(v1[0], v1[1]); w.w = cvt_pk_bf16(v1[2], v1[3]);
                    st16_wt(rowp + bj * 128, w); } }
    }
};

__device__ __forceinline__ int nmap(int n, int mode, int roff) { return mode == 0 ? n + roff : (mode == 1 ? ((n >> 7) * 256 + (n & 127)) : ((n >> 7) * 256 + 128 + (n & 127))); }
__device__ __forceinline__ void tr_item(const float* W, int K, int N, bf16_t* dst, int ldk, int koff, int mode, int roff, const float* ks, LAS float* scr, int item, int lane) {
    const int nblk = (N + 31) >> 5, kb = item / nblk, nb = item - kb * nblk, k0 = 64 * kb, n0 = 32 * nb;
    const int nl = n0 + (lane & 31);
    const int c = lane & 7;
    f32x4 sc0 = {1.f, 1.f, 1.f, 1.f}, sc1 = {1.f, 1.f, 1.f, 1.f};
    if (ks) { sc0 = *(const f32x4*)(ks + k0 + 8 * c); sc1 = *(const f32x4*)(ks + k0 + 8 * c + 4); }
#pragma unroll
    for (int i = 0; i < 32; ++i) { const int kk = 2 * i + (lane >> 5); float v = 0.f;
        if (nl < N) v = W[(size_t)(k0 + kk) * N + nl];
        scr[kk * 33 + (lane & 31)] = v; }
    LDS_FENCE();
#pragma unroll
    for (int j = 0; j < 4; ++j) { const int nn = (lane >> 3) + 8 * j; const LAS float* s = scr + (8 * c) * 33 + nn;
        u32x4 o; o.x = cvt_pk_bf16(s[0 * 33] * sc0[0], s[1 * 33] * sc0[1]); o.y = cvt_pk_bf16(s[2 * 33] * sc0[2], s[3 * 33] * sc0[3]); o.z = cvt_pk_bf16(s[4 * 33] * sc1[0], s[5 * 33] * sc1[1]); o.w = cvt_pk_bf16(s[6 * 33] * sc1[2], s[7 * 33] * sc1[3]);
        if (n0 + nn < N) *(u32x4*)(dst + (size_t)nmap(n0 + nn, mode, roff) * ldk + koff + k0 + 8 * c) = o; }
    LDS_FENCE();
}
__device__ __forceinline__ void ph_convert(const Params& P, int L, LAS unsigned char* lds, int tid) {
    const int lane = tid & 63, wid = tid >> 6;
    const int gw = blockIdx.x * 8 + wid, NGW = gridDim.x * 8, gtid = blockIdx.x * 512 + tid, NTH = gridDim.x * 512;
    LAS float* scr = (LAS float*)(lds + wid * 8704);
    const int j = L >> 1; const bool odd = (L & 1) != 0;
    bf16_t* Wb = (bf16_t*)(PWS() + OFF_W) + (odd ? WO_BASE : 0);
    int it = gw;
#define JOB(Wsrc, K_, N_, dst_, ldk_, koff_, mode_, roff_, ks_) { const int ni = ((K_) / 64) * (((N_) + 31) / 32); \
        for (; it < ni; it += NGW) tr_item((Wsrc), (K_), (N_), (dst_), (ldk_), (koff_), (mode_), (roff_), (ks_), scr, it, lane); it -= ni; }
    if (!odd) {
        JOB(PIN(6) + (size_t)j * 1024 * 3080, 1024, 3080, Wb + WE_IN, 1024, 0, 0, 0, PIN(2) + L * 1024)
        JOB(PIN(18) + (size_t)j * 1024 * 1024, 1024, 1024, Wb + WE_OUT, 1024, 0, 0, 0, (const float*)nullptr)
    } else {
        JOB(PIN(19) + (size_t)j * 1024 * 3840, 1024, 3840, Wb + WO_IN, 1024, 0, 0, 0, PIN(2) + L * 1024)
        JOB(PIN(24) + (size_t)j * 64 * 512, 64, 512, Wb + WO_LORA, 256, 0, 0, 0, (const float*)nullptr)
        JOB(PIN(26) + (size_t)j * 64 * 512, 64, 512, Wb + WO_LORA, 256, 64, 0, 512, (const float*)nullptr)
        JOB(PIN(27) + (size_t)j * 128 * 512, 128, 512, Wb + WO_LORA, 256, 128, 0, 1024, (const float*)nullptr)
        JOB(PIN(33) + (size_t)j * 1024 * 1024, 1024, 1024, Wb + WO_OUT, 1024, 0, 0, 0, (const float*)nullptr)
    }
    bf16_t* Wgu = Wb + (odd ? WO_GU : WE_GU); bf16_t* Wdn = Wb + (odd ? WO_DN : WE_DN); bf16_t* Wpg = Wb + (odd ? WO_PG : WE_PG); bf16_t* Wpu = Wb + (odd ? WO_PU : WE_PU);
    JOB(PIN(34) + (size_t)L * 1024 * 2816, 1024, 2816, Wgu, 1024, 0, 1, 0, PIN(3) + L * 1024)
    JOB(PIN(35) + (size_t)L * 1024 * 2816, 1024, 2816, Wgu, 1024, 0, 2, 0, PIN(3) + L * 1024)
    JOB(PIN(36) + (size_t)L * 2816 * 1024, 2816, 1024, Wdn, 2816, 0, 0, 0, (const float*)nullptr)
    JOB(PIN(38) + (size_t)L * 1024 * 1024, 1024, 1024, Wpg, 1024, 0, 0, 0, PIN(4) + L * 1024)
    JOB(PIN(37) + (size_t)L * 256 * 1024, 256, 1024, Wpu, 256, 0, 0, 0, (const float*)nullptr)
#undef JOB
    const u32x4 zero4 = zero_u4();
    if (!odd) {
        u32x4* zp = (u32x4*)(Wb + WE_IN + (size_t)3080 * 1024);
        for (int i = gtid; i < 248 * 128; i += NTH) zp[i] = zero4;
    } else {
        u32x4* zp = (u32x4*)(Wb + WO_LORA);
        for (int ch = gtid; ch < 1536 * 32; ch += NTH) { const int n = ch >> 5, c = ch & 31, kind = n >> 9;
            const bool live = kind == 0 ? (c < 8) : (kind == 1 ? (c >= 8 && c < 16) : (c >= 16));
            if (!live) zp[ch] = zero4; }
    }
}

__device__ __forceinline__ void ph_convert_p(const Params& P, int L, int tid) {
    const int gtid = blockIdx.x * 512 + tid, NTH = gridDim.x * 512;
    const float* p = PIN(1) + (size_t)L * T * 256; u32x4* pb = (u32x4*)(PWS() + OFF_PB);
    for (int i0 = gtid; i0 < T * 32; i0 += 4 * NTH) {
        f32x4 a[4], b[4];
#pragma unroll
        for (int e = 0; e < 4; ++e) { const int i = i0 + e * NTH; if (i < T * 32) { a[e] = *(const f32x4*)(p + (size_t)i * 8); b[e] = *(const f32x4*)(p + (size_t)i * 8 + 4); } else { a[e] = (f32x4){0.f, 0.f, 0.f, 0.f}; b[e] = a[e]; } }
#pragma unroll
        for (int e = 0; e < 4; ++e) { const int i = i0 + e * NTH; if (i < T * 32) { u32x4 w; w.x = cvt_pk_bf16(a[e][0], a[e][1]); w.y = cvt_pk_bf16(a[e][2], a[e][3]); w.z = cvt_pk_bf16(b[e][0], b[e][1]); w.w = cvt_pk_bf16(b[e][2], b[e][3]); pb[i] = w; } }
    }
}

__device__ __forceinline__ void ph_prologue(const Params& P, int tid) {
    const int lane = tid & 63, gw = blockIdx.x * 8 + (tid >> 6), NGW = gridDim.x * 8;
    const float* x = PIN(0); bf16_t* hb = (bf16_t*)(PWS() + OFF_HB); float* ssA = (float*)(PWS() + OFF_SS);
    for (int row0 = gw; row0 < T; row0 += 4 * NGW) {
        f32x4 v[4][4];
#pragma unroll
        for (int e = 0; e < 4; ++e) { const int row = row0 + e * NGW;
#pragma unroll
            for (int q = 0; q < 4; ++q) v[e][q] = (row < T) ? *((const f32x4*)(x + (size_t)row * 1024) + lane + 64 * q) : (f32x4){0.f, 0.f, 0.f, 0.f}; }
#pragma unroll
        for (int e = 0; e < 4; ++e) { const int row = row0 + e * NGW; if (row < T) { u32x2* br = (u32x2*)(hb + (size_t)row * 1024) + lane; float s = 0.f;
#pragma unroll
            for (int q = 0; q < 4; ++q) { const f32x4 w4 = v[e][q]; s += (w4[0] * w4[0] + w4[1] * w4[1]) + (w4[2] * w4[2] + w4[3] * w4[3]); u32x2 w; w.x = cvt_pk_bf16(w4[0], w4[1]); w.y = cvt_pk_bf16(w4[2], w4[3]); br[64 * q] = w; }
            s = wave_sum(s); if (lane < 16) ssA[(size_t)row * 16 + lane] = (lane == 0) ? s : 0.f; } }
    }
}
__device__ __forceinline__ void zero_f32(float* p, int n, int tid) { for (int i = blockIdx.x * 512 + tid; i < n; i += gridDim.x * 512) p[i] = 0.f; }
__device__ __forceinline__ void ph_final(const Params& P, int tid) {
    const int lane = tid & 63, gw = blockIdx.x * 8 + (tid >> 6), NGW = gridDim.x * 8;
    float* out = POUT(); const bf16_t* h = (const bf16_t*)(PWS() + OFF_HB); const float* ssA = (const float*)(PWS() + OFF_SS); const float* nw = PIN(5);
    f32x4 w0[2], w1[2];
#pragma unroll
    for (int q = 0; q < 2; ++q) { const int c = q * 512 + lane * 8; w0[q] = *(const f32x4*)(nw + c); w1[q] = *(const f32x4*)(nw + c + 4); }
    for (int row0 = gw; row0 < T; row0 += 4 * NGW) {
        u32x4 hv[4][2]; float rsv[4];
#pragma unroll
        for (int e = 0; e < 4; ++e) { const int row = row0 + e * NGW; const bool ok = row < T; rsv[e] = ok ? rsqrtf(rowss(ssA, row) * (1.0f / 1024.0f) + 1e-6f) : 0.f;
#pragma unroll
            for (int q = 0; q < 2; ++q) hv[e][q] = ok ? *(const u32x4*)(h + (size_t)row * 1024 + q * 512 + lane * 8) : (u32x4){0u, 0u, 0u, 0u}; }
#pragma unroll
        for (int e = 0; e < 4; ++e) { const int row = row0 + e * NGW; if (row < T) { const float rs = rsv[e];
#pragma unroll
            for (int q = 0; q < 2; ++q) { const int c = q * 512 + lane * 8; float hf[8]; unpack8(hv[e][q], hf);
                *(f32x4*)(out + (size_t)row * 1024 + c) = (f32x4){hf[0] * rs * w0[q][0], hf[1] * rs * w0[q][1], hf[2] * rs * w0[q][2], hf[3] * rs * w0[q][3]};
                *(f32x4*)(out + (size_t)row * 1024 + c + 4) = (f32x4){hf[4] * rs * w1[q][0], hf[5] * rs * w1[q][1], hf[6] * rs * w1[q][2], hf[7] * rs * w1[q][3]}; } } }
    }
}

__device__ __forceinline__ void ph_rg_prep(const Params& P, int j, LAS unsigned char* lds, int tid) {
    const int lane = tid & 63, g = tid >> 6, quad = lane >> 4, fr = lane & 15;
    const bf16_t* Z = (const bf16_t*)(PWS() + OFF_Z); bf16_t* HB = (bf16_t*)((unsigned char*)tabptr(41));
    LAS bf16_t* xb = (LAS bf16_t*)lds;
    const float* wr_ = PIN(9) + (size_t)(j * 8 + g) * 4096; const float* wi_ = PIN(11) + (size_t)(j * 8 + g) * 4096;
    bf16x8 Br[4][2], Bi[4][2];
#pragma unroll
    for (int nt = 0; nt < 4; ++nt)
#pragma unroll
        for (int ks = 0; ks < 2; ++ks) {
            float a[8], b[8];
#pragma unroll
            for (int q = 0; q < 8; ++q) { const int i = ks * 32 + quad * 8 + q, jj = nt * 16 + fr; a[q] = wr_[i * 64 + jj]; b[q] = wi_[i * 64 + jj]; }
            const u32x4 pa = pack8(a), pb = pack8(b); Br[nt][ks] = __builtin_bit_cast(bf16x8, pa); Bi[nt][ks] = __builtin_bit_cast(bf16x8, pb);
        }
    const int c0 = (tid & 63) * 8;
    float cw[4][8], cb[8];
#pragma unroll
    for (int k = 0; k < 4; ++k)
#pragma unroll
        for (int q = 0; q < 8; ++q) cw[k][q] = PIN(7)[(size_t)(j * 4 + k) * 512 + c0 + q];
#pragma unroll
    for (int q = 0; q < 8; ++q) cb[q] = PIN(8)[j * 512 + c0 + q];
    float ebr[4], ebi[4], espl[4];
#pragma unroll
    for (int nt = 0; nt < 4; ++nt) { const int col = g * 64 + nt * 16 + fr; ebr[nt] = PIN(10)[j * 512 + col]; ebi[nt] = PIN(12)[j * 512 + col]; espl[nt] = softplusf_(-PIN(13)[j * 512 + col]); }

    const int tg = tid >> 6;
    const u32x4 z4 = zero_u4();
    u32x4 rw[11];
#define RG_ROWS(tile_) { const int r0_ = (tile_) * 64 + tg * 8 - 3; _Pragma("unroll") for (int i = 0; i < 11; ++i) rw[i] = (r0_ + i >= 0) ? *(const u32x4*)(Z + (size_t)(r0_ + i) * EVN + c0) : z4; }
    if ((int)blockIdx.x < T / 64) RG_ROWS((int)blockIdx.x)
    for (int tile = blockIdx.x; tile < T / 64; tile += gridDim.x) {
        const int t0 = tile * 64, s0 = t0 & (SEQ - 1);
#pragma unroll
        for (int it = 0; it < 8; ++it) {
            const int tok = tg * 8 + it;
            float a8[8];
#pragma unroll
            for (int q = 0; q < 8; ++q) a8[q] = cb[q];
#pragma unroll
            for (int k = 0; k < 4; ++k) {
                if (s0 + tok - 3 + k >= 0) { float xf[8]; unpack8(rw[it + k], xf);
#pragma unroll
                    for (int q = 0; q < 8; ++q) a8[q] += cw[k][q] * xf[q]; } }
            *(LAS u32x4*)(xb + tok * 520 + c0) = pack8(a8);
        }
        if (tile + (int)gridDim.x < T / 64) RG_ROWS(tile + (int)gridDim.x)
        __syncthreads();
#pragma unroll 1
        for (int mt = 0; mt < 4; ++mt) {
            f32x4 dr[4], di[4];
#pragma unroll
            for (int nt = 0; nt < 4; ++nt) { dr[nt] = (f32x4){0.f, 0.f, 0.f, 0.f}; di[nt] = (f32x4){0.f, 0.f, 0.f, 0.f}; }
#pragma unroll
            for (int ks = 0; ks < 2; ++ks) {
                const bf16x8 a = *(const LAS bf16x8*)(xb + (mt * 16 + fr) * 520 + g * 64 + ks * 32 + quad * 8);
#pragma unroll
                for (int nt = 0; nt < 4; ++nt) { dr[nt] = __builtin_amdgcn_mfma_f32_16x16x32_bf16(a, Br[nt][ks], dr[nt], 0, 0, 0); di[nt] = __builtin_amdgcn_mfma_f32_16x16x32_bf16(a, Bi[nt][ks], di[nt], 0, 0, 0); }
            }
#pragma unroll
            for (int nt = 0; nt < 4; ++nt) {
                const int col = g * 64 + nt * 16 + fr;
#pragma unroll
                for (int q = 0; q < 4; ++q) {
                    const int tok = mt * 16 + quad * 4 + q; const float xv = bf2f(xb[tok * 520 + col]);
                    const float r = sigmoidf_(dr[nt][q] + ebr[nt]), ig = sigmoidf_(di[nt][q] + ebi[nt]);
                    const float la = -8.0f * r * espl[nt];
                    const float mult = (s0 + tok == 0) ? 1.0f : __builtin_amdgcn_sqrtf(fmaxf(1.0f - __expf(2.0f * la), 0.f));
                    const float uu = mult * ig * xv;
                    HB[(size_t)(t0 + tok) * 1024 + col] = f2bf(la); HB[(size_t)(t0 + tok) * 1024 + 512 + col] = f2bf(uu);
                }
            }
        }
        __syncthreads();
    }
}

#undef RG_ROWS
__device__ __forceinline__ void ph_rg_scan(const Params& P, int task, LAS unsigned char* lds, int tid) {
    const int b = task >> 5, cl = tid & 15, c = (task & 31) * 16 + cl, seg = tid >> 4;
    const bf16_t* Z = (const bf16_t*)(PWS() + OFF_Z); const bf16_t* HB = (const bf16_t*)((unsigned char*)tabptr(41)); bf16_t* MIX = (bf16_t*)((unsigned char*)tabptr(42));
    LAS float* sSL = (LAS float*)lds; LAS float* sH = sSL + 512;
    const size_t tb = (size_t)b * SEQ + (size_t)seg * 128;
    float H = 0.f, SL = 0.f;
    {
        bf16_t la16[16], u16[16], nla[16], nu[16];
#pragma unroll
        for (int k = 0; k < 16; ++k) { la16[k] = HB[(tb + k) * 1024 + c]; u16[k] = HB[(tb + k) * 1024 + 512 + c]; }
#pragma unroll 1
        for (int i0 = 0; i0 < 128; i0 += 16) {
            if (i0 + 16 < 128) {
#pragma unroll
                for (int k = 0; k < 16; ++k) { nla[k] = HB[(tb + i0 + 16 + k) * 1024 + c]; nu[k] = HB[(tb + i0 + 16 + k) * 1024 + 512 + c]; } }
#pragma unroll
            for (int k = 0; k < 16; ++k) { const float la = bf2f(la16[k]); H = __expf(la) * H + bf2f(u16[k]); SL += la; }
#pragma unroll
            for (int k = 0; k < 16; ++k) { la16[k] = nla[k]; u16[k] = nu[k]; }
        }
    }
    sSL[tid] = SL; sH[tid] = H;
    __syncthreads();
    float hc = 0.f;
    for (int s2 = 0; s2 < seg; ++s2) hc = __expf(sSL[s2 * 16 + cl]) * hc + sH[s2 * 16 + cl];
    H = hc;
    {
        bf16_t la16[16], u16[16], ya16[16], nla[16], nu[16], nya[16], o16[16];
#pragma unroll
        for (int k = 0; k < 16; ++k) { la16[k] = HB[(tb + k) * 1024 + c]; u16[k] = HB[(tb + k) * 1024 + 512 + c]; ya16[k] = Z[(tb + k) * EVN + 512 + c]; }
#pragma unroll 1
        for (int i0 = 0; i0 < 128; i0 += 16) {
            if (i0 + 16 < 128) {
#pragma unroll
                for (int k = 0; k < 16; ++k) { nla[k] = HB[(tb + i0 + 16 + k) * 1024 + c]; nu[k] = HB[(tb + i0 + 16 + k) * 1024 + 512 + c]; nya[k] = Z[(tb + i0 + 16 + k) * EVN + 512 + c]; } }
#pragma unroll
            for (int k = 0; k < 16; ++k) { H = __expf(bf2f(la16[k])) * H + bf2f(u16[k]); o16[k] = f2bf(H * gelu_tanh(bf2f(ya16[k]))); }
#pragma unroll
            for (int k = 0; k < 16; ++k) MIX[(tb + i0 + k) * 1024 + c] = o16[k];
#pragma unroll
            for (int k = 0; k < 16; ++k) { la16[k] = nla[k]; u16[k] = nu[k]; ya16[k] = nya[k]; }
        }
    }
    __syncthreads();
}

__device__ __forceinline__ void ph_gdn_prep(const Params& P, int j, int tid) {
    const int lane = tid & 63, gw = blockIdx.x * 8 + (tid >> 6), NGW = gridDim.x * 8;
    const int role = gw % 3, wi = gw / 3, nW = (NGW - role + 2) / 3;
    const bf16_t* Z = (const bf16_t*)(PWS() + OFF_Z); bf16_t* QK = (bf16_t*)(PWS() + OFF_QK); bf16_t* VP = (bf16_t*)(PWS() + OFF_EXT); float* GT = (float*)(PWS() + OFF_LA);
    const int head = lane >> 4, il = lane & 15, ch = head * 128 + il * 8;
    float cw[4][8];
#pragma unroll
    for (int k = 0; k < 4; ++k)
#pragma unroll
        for (int q = 0; q < 8; ++q) cw[k][q] = PIN(14)[(size_t)(j * 4 + k) * 1536 + role * 512 + ch + q];
    const float nalog = (lane < 4) ? -__expf(PIN(15)[j * 4 + (lane & 3)]) : 0.f, dtb = (lane < 4) ? PIN(16)[j * 4 + (lane & 3)] : 0.f;
    const int per = (T + nW - 1) / nW, tb = wi * per, te = (tb + per < T) ? (tb + per) : T;
    if (tb < te) {
        const u32x4 z4 = zero_u4();
        const bf16_t* zc = Z + 1024 + role * 512 + ch;
        u32x4 rows[7], nx[4];
#pragma unroll
        for (int i = 0; i < 7; ++i) { const int r = tb - 3 + i; rows[i] = (r >= 0 && r < T) ? *(const u32x4*)(zc + (size_t)r * EVN) : z4; }
        bf16_t ga[4] = {0, 0, 0, 0}, gb[4] = {0, 0, 0, 0};
        if (role == 2 && lane < 4) {
#pragma unroll
            for (int e = 0; e < 4; ++e) { const int tt = tb + e; if (tt < te) { ga[e] = Z[(size_t)tt * EVN + 3072 + lane]; gb[e] = Z[(size_t)tt * EVN + 3076 + lane]; } } }
#pragma unroll 1
        for (int t = tb; t < te; t += 4) {
#pragma unroll
            for (int i = 0; i < 4; ++i) { const int r = t + 4 + i; nx[i] = (t + 4 < te && r < T) ? *(const u32x4*)(zc + (size_t)r * EVN) : z4; }
            bf16_t na[4] = {0, 0, 0, 0}, nb[4] = {0, 0, 0, 0};
            if (role == 2 && lane < 4) {
#pragma unroll
                for (int e = 0; e < 4; ++e) { const int tt = t + 4 + e; if (tt < te) { na[e] = Z[(size_t)tt * EVN + 3072 + lane]; nb[e] = Z[(size_t)tt * EVN + 3076 + lane]; } } }
#pragma unroll
            for (int e = 0; e < 4; ++e) { const int tt = t + e; if (tt < te) {
                const int s0 = tt & (SEQ - 1);
                float a8[8];
#pragma unroll
                for (int q = 0; q < 8; ++q) a8[q] = 0.f;
#pragma unroll
                for (int k = 0; k < 4; ++k) { float xf[8]; unpack8((s0 - 3 + k >= 0) ? rows[e + k] : z4, xf);
#pragma unroll
                    for (int q = 0; q < 8; ++q) a8[q] += cw[k][q] * xf[q]; }
                float ss = 0.f;
#pragma unroll
                for (int q = 0; q < 8; ++q) { a8[q] = siluf_(a8[q]); ss += a8[q] * a8[q]; }
                if (role < 2) { ss = rowsum16(ss); const float sc = rsqrtf(ss + 1e-6f) * (role == 0 ? 0.08838834764831845f : 1.0f);
#pragma unroll
                    for (int q = 0; q < 8; ++q) a8[q] *= sc;
                    *(u32x4*)(QK + (size_t)tt * 1024 + head * 256 + role * 128 + il * 8) = pack8(a8); }
                else { *(u32x4*)(VP + (size_t)tt * 512 + ch) = pack8(a8);
                    if (lane < 4) { GT[(size_t)tt * 8 + lane] = __expf(nalog * softplusf_(bf2f(ga[e]) + dtb)); GT[(size_t)tt * 8 + 4 + lane] = sigmoidf_(bf2f(gb[e])); } } } }
#pragma unroll
            for (int e = 0; e < 4; ++e) { ga[e] = na[e]; gb[e] = nb[e]; }
            rows[0] = rows[4]; rows[1] = rows[5]; rows[2] = rows[6];
#pragma unroll
            for (int i = 0; i < 4; ++i) rows[3 + i] = nx[i];
        }
    }
}

__device__ __forceinline__ void ph_gdn(const Params& P, int j, int task, LAS unsigned char* lds, int tid) {
    const int lane = tid & 63, wid = tid >> 6;
    const int bh = task >> 3, b = bh >> 2, hh = bh & 3, cgp = task & 7;
    const bf16_t* QK = (const bf16_t*)(PWS() + OFF_QK); const bf16_t* VP = (const bf16_t*)(PWS() + OFF_EXT); const float* GT = (const float*)(PWS() + OFF_LA); bf16_t* MIX = (bf16_t*)((unsigned char*)tabptr(42));
    constexpr int NC = SEQ / 32, STB = 35328;
    LAS unsigned char* stg = lds;
    LAS bf16_t* soutb = (LAS bf16_t*)(lds + 2 * STB);
    const bool stager = wid >= 4; const int stid = tid - 256;
    f32x4 S4[2];
#pragma unroll
    for (int q = 0; q < 2; ++q) S4[q] = (f32x4){0.f, 0.f, 0.f, 0.f};
    u32x4 R[5]; float ga = 0.f, gb = 0.f;
    const u32x4 zero4 = zero_u4();
#define GDN_LOAD(cc) { const size_t t0_ = (size_t)b * SEQ + (size_t)(cc) * 32; _Pragma("unroll") for (int i = 0; i < 5; ++i) { const int p = stid + 256 * i; \
        if (p < 1024) R[i] = *(const u32x4*)(QK + (t0_ + (p >> 5)) * 1024 + hh * 256 + (p & 31) * 8); \
        else if (p < 1088) R[i] = *(const u32x4*)(VP + (t0_ + ((p - 1024) >> 1)) * 512 + hh * 128 + cgp * 16 + ((p - 1024) & 1) * 8); \
        else R[i] = zero4; } \
        if (stid < 32) { ga = GT[(t0_ + stid) * 8 + hh]; gb = GT[(t0_ + stid) * 8 + 4 + hh]; } }
#define GDN_TRANSFORM(buf) { LAS float* sq_ = (LAS float*)(stg + (buf) * STB); LAS float* sk_ = sq_ + 32 * 128; LAS float* sv_ = sk_ + 32 * 128; LAS float* seg_ = sv_ + 32 * 16; LAS float* sbt_ = seg_ + 32; \
        _Pragma("unroll") for (int i = 0; i < 5; ++i) { const int p = stid + 256 * i; float xf[8]; unpack8(R[i], xf); LAS float* dst = nullptr; \
            if (p < 1024) { const int rr = p >> 5, pc = p & 31; dst = (pc < 16) ? (sq_ + rr * 128 + pc * 8) : (sk_ + rr * 128 + (pc - 16) * 8); } \
            else if (p < 1088) { dst = sv_ + ((p - 1024) >> 1) * 16 + ((p - 1024) & 1) * 8; } \
            if (p < 1088) { *(LAS f32x4*)dst = (f32x4){xf[0], xf[1], xf[2], xf[3]}; *(LAS f32x4*)(dst + 4) = (f32x4){xf[4], xf[5], xf[6], xf[7]}; } } \
        if (stid < 32) { seg_[stid] = ga; sbt_[stid] = gb; } }
#define GDN_FLUSH(cc) { if (stid < 64) { const int s_ = stid >> 1, pc = stid & 1; \
        *(u32x4*)(MIX + (size_t)(b * SEQ + (cc) * 32 + s_) * 1024 + 512 + hh * 128 + cgp * 16 + pc * 8) = *(const LAS u32x4*)(soutb + ((cc) & 1) * 512 + s_ * 16 + pc * 8); } }
#define GDN_REC(buf, s_lo, cc) { const LAS float* sq_ = (const LAS float*)(stg + (buf) * STB); const LAS float* sk_ = sq_ + 32 * 128; const LAS float* sv_ = sk_ + 32 * 128; const LAS float* seg_ = sv_ + 32 * 16; const LAS float* sbt_ = seg_ + 32; \
        LAS bf16_t* so_ = soutb + ((cc) & 1) * 512; \
        f32x4 ck[2], cq[2], pq[2]; \
        _Pragma("unroll") for (int i = 0; i < 2; ++i) { ck[i] = *(const LAS f32x4*)(sk_ + (s_lo) * 128 + 64 * i + rq); cq[i] = *(const LAS f32x4*)(sq_ + (s_lo) * 128 + 64 * i + rq); pq[i] = cq[i]; } \
        float cv = sv_[(s_lo) * 16 + col], ceg = seg_[(s_lo)], cbt = sbt_[(s_lo)]; float oacc = 0.f; \
        _Pragma("unroll") for (int u = 0; u < 16; ++u) { const int sn = (s_lo) + u + 1; \
            f32x4 nk[2], nq[2]; \
            _Pragma("unroll") for (int i = 0; i < 2; ++i) { nk[i] = *(const LAS f32x4*)(sk_ + sn * 128 + 64 * i + rq); nq[i] = *(const LAS f32x4*)(sq_ + sn * 128 + 64 * i + rq); } \
            const float nv = sv_[sn * 16 + col], neg = seg_[sn], nbt = sbt_[sn]; \
              \
            f32x2 a2 = ck[0].xy * S4[0].xy, b2 = pq[0].xy * S4[0].xy; a2 += ck[0].zw * S4[0].zw; b2 += pq[0].zw * S4[0].zw; a2 += ck[1].xy * S4[1].xy; b2 += pq[1].xy * S4[1].xy; a2 += ck[1].zw * S4[1].zw; b2 += pq[1].zw * S4[1].zw;     \
            float pk = a2[0] + a2[1], pp = b2[0] + b2[1]; \
            pk += dppf<0xB1>(pk); pp += dppf<0xB1>(pp); pk += dppf<0x4E>(pk); pp += dppf<0x4E>(pp); pk += dppf<0x141>(pk); pp += dppf<0x141>(pp); pk += dppf<0x140>(pk); pp += dppf<0x140>(pp); \
            if (u > 0) oacc = (il == u - 1) ? pp : oacc; \
            const float dl = cbt * (cv - ceg * pk); \
            _Pragma("unroll") for (int i = 0; i < 2; ++i) S4[i] = S4[i] * ceg + ck[i] * dl; \
            _Pragma("unroll") for (int i = 0; i < 2; ++i) { pq[i] = cq[i]; ck[i] = nk[i]; cq[i] = nq[i]; } \
            cv = nv; ceg = neg; cbt = nbt; \
            __builtin_amdgcn_sched_barrier(0); } \
        { f32x2 b2 = pq[0].xy * S4[0].xy; b2 += pq[0].zw * S4[0].zw; b2 += pq[1].xy * S4[1].xy; b2 += pq[1].zw * S4[1].zw; float pp = b2[0] + b2[1]; pp = rowsum16(pp); \
          oacc = (il == 15) ? pp : oacc; so_[((s_lo) + il) * 16 + col] = f2bf(oacc); } }
    const int il = lane & 15, col = (wid & 3) * 4 + (lane >> 4), rq = il * 4;
    if (stager) { GDN_LOAD(0) GDN_TRANSFORM(0) GDN_LOAD(1) } else __builtin_amdgcn_s_setprio(2);
    __syncthreads();
#pragma unroll 1
    for (int c = 0; c < NC; ++c) {
        if (stager) { if (c > 0) GDN_FLUSH(c - 1) }
        else GDN_REC(c & 1, 0, c)
        __syncthreads();
        if (stager) { if (c + 1 < NC) GDN_TRANSFORM((c + 1) & 1) if (c + 2 < NC) GDN_LOAD(c + 2) }
        else GDN_REC(c & 1, 16, c)
        __syncthreads();
    }
    if (stager) GDN_FLUSH(NC - 1) else __builtin_amdgcn_s_setprio(0);
#undef GDN_LOAD
#undef GDN_TRANSFORM
#undef GDN_FLUSH
#undef GDN_REC
    __syncthreads();
}

__device__ __forceinline__ void ph_gdn_post(const Params& P, int j, int tid) {
    const int lane = tid & 63, gw = blockIdx.x * 8 + (tid >> 6), NGW = gridDim.x * 8;
    const bf16_t* Z = (const bf16_t*)(PWS() + OFF_Z); bf16_t* MIX = (bf16_t*)((unsigned char*)tabptr(42));
    const int head = lane >> 4, il = lane & 15;
    float nw[8];
#pragma unroll
    for (int q = 0; q < 8; ++q) nw[q] = PIN(17)[j * 128 + il * 8 + q];
    u32x4 wo[2], wz[2], nwo[2], nwz[2];
    const u32x4 z4 = zero_u4();
#define GP_LOAD(WO, WZ, t0_) { _Pragma("unroll") for (int e = 0; e < 2; ++e) { const int t = (t0_) + e * NGW; \
        if (t < T) { WO[e] = *(const u32x4*)(MIX + (size_t)t * 1024 + 512 + head * 128 + il * 8); WZ[e] = *(const u32x4*)(Z + (size_t)t * EVN + 2560 + head * 128 + il * 8); } else { WO[e] = z4; WZ[e] = z4; } } }
    GP_LOAD(wo, wz, gw)
    for (int t0 = gw; t0 < T; t0 += 2 * NGW) {
        GP_LOAD(nwo, nwz, t0 + 2 * NGW)
#pragma unroll
        for (int e = 0; e < 2; ++e) { const int t = t0 + e * NGW; if (t < T) {
            float o[8], zg[8]; unpack8(wo[e], o); unpack8(wz[e], zg);
            float ss = 0.f;
#pragma unroll
            for (int q = 0; q < 8; ++q) ss += o[q] * o[q];
            ss = rowsum16(ss); const float rs = rsqrtf(ss * (1.0f / 128.0f) + 1e-6f);
#pragma unroll
            for (int q = 0; q < 8; ++q) o[q] = o[q] * rs * nw[q] * siluf_(zg[q]);
            *(u32x4*)(MIX + (size_t)t * 1024 + 512 + head * 128 + il * 8) = pack8(o); } }
#pragma unroll
        for (int e = 0; e < 2; ++e) { wo[e] = nwo[e]; wz[e] = nwz[e]; }
    }
#undef GP_LOAD
}

__device__ __forceinline__ void ph_lora_prep(const Params& P, int j, int tid) {
    const bf16_t* Z = (const bf16_t*)(PWS() + OFF_Z); bf16_t* LA = (bf16_t*)(PWS() + OFF_LA);
    const int grp = tid & 31;
    float mu[8];
#pragma unroll
    for (int q = 0; q < 8; ++q) mu[q] = PIN(22)[(size_t)j * 1792 + 1536 + grp * 8 + q];
    const int NTH = gridDim.x * 512;
    for (int item0 = blockIdx.x * 512 + tid; item0 < T * 32; item0 += 4 * NTH) {
        u32x4 wc[4], wp[4];
#pragma unroll
        for (int e = 0; e < 4; ++e) { const int item = item0 + e * NTH; const int t = item >> 5; const size_t zo = (size_t)t * ODN + 2048 + 1536 + grp * 8;
            wc[e] = (item < T * 32) ? *(const u32x4*)(Z + zo) : (u32x4){0u, 0u, 0u, 0u};
            wp[e] = (item < T * 32 && (t & (SEQ - 1)) != 0) ? *(const u32x4*)(Z + zo - ODN) : (u32x4){0u, 0u, 0u, 0u}; }
#pragma unroll
        for (int e = 0; e < 4; ++e) { const int item = item0 + e * NTH; if (item < T * 32) { const int t = item >> 5;
            float cur[8], prv[8], o[8]; unpack8(wc[e], cur); unpack8(wp[e], prv);
#pragma unroll
            for (int q = 0; q < 8; ++q) { const float m = cur[q] + mu[q] * (prv[q] - cur[q]); o[q] = grp < 8 ? (1.0f - 2.0f * __builtin_amdgcn_rcpf(1.0f + __expf(2.0f * m))) : (grp < 16 ? m : sigmoidf_(m));     }
            *(u32x4*)(LA + (size_t)t * 256 + grp * 8) = pack8(o); } }
    }
}

__device__ __forceinline__ void ph_hgrn(const Params& P, int j, int task, LAS unsigned char* lds, int tid) {
    const int lane = tid & 63, wid = tid >> 6;
    const int bh = task >> 2, b = bh >> 2, hh = bh & 3, cgp = task & 3;
    const bf16_t* Z = (const bf16_t*)(PWS() + OFF_Z); bf16_t* MIX = (bf16_t*)((unsigned char*)tabptr(42));
    constexpr int NC = SEQ / 32, STB = 37120;
    LAS unsigned char* stg = lds; LAS bf16_t* soutb = (LAS bf16_t*)(lds + 2 * STB); LAS float* slb = (LAS float*)(lds + 2 * STB + 4096);
    if (tid < 128) { float lb = 0.f; if (j > 0) { const float x0 = PIN(20)[hh * 128 + tid], x1 = PIN(20)[512 + hh * 128 + tid]; lb = fmaxf(sigmoidf_(x1 - x0), 0.f); } slb[tid] = lb; }
    __syncthreads();
    const bool stager = wid >= 4; const int stid = tid - 256;
    f32x4 S4[4];
#pragma unroll
    for (int q = 0; q < 4; ++q) S4[q] = (f32x4){0.f, 0.f, 0.f, 0.f};
    u32x4 R[5];
    const u32x4 zero4 = zero_u4();
#define HG_LOAD(cc) { const size_t t0_ = (size_t)b * SEQ + (size_t)(cc) * 32; _Pragma("unroll") for (int i = 0; i < 5; ++i) { const int p = stid + 256 * i; const int rr = p / 36, pc = p - rr * 36; \
        const int col = pc < 16 ? (hh * 128 + pc * 8) : (pc < 32 ? (512 + hh * 128 + (pc - 16) * 8) : (1024 + hh * 128 + cgp * 32 + (pc - 32) * 8)); \
        R[i] = (p < 1152) ? *(const u32x4*)(Z + (t0_ + rr) * ODN + col) : zero4; } }
#define HG_TRANSFORM(buf) { LAS float* sq_ = (LAS float*)(stg + (buf) * STB); LAS float* sf_ = sq_ + 32 * 128; LAS float* sv_ = sf_ + 32 * 128; \
        _Pragma("unroll") for (int i = 0; i < 5; ++i) { const int p = stid + 256 * i; if (p < 1152) { const int rr = p / 36, pc = p - rr * 36; float xf[8]; unpack8(R[i], xf); LAS float* dst; \
            if (pc < 16) { _Pragma("unroll") for (int q = 0; q < 8; ++q) xf[q] = siluf_(xf[q]); dst = sq_ + rr * 128 + pc * 8; } \
            else if (pc < 32) { const int d0 = (pc - 16) * 8; _Pragma("unroll") for (int q = 0; q < 8; ++q) { const float lb = slb[d0 + q]; xf[q] = lb + (1.0f - lb) * sigmoidf_(xf[q]); } dst = sf_ + rr * 128 + d0; } \
            else dst = sv_ + rr * 32 + (pc - 32) * 8; \
            *(LAS f32x4*)dst = (f32x4){xf[0], xf[1], xf[2], xf[3]}; *(LAS f32x4*)(dst + 4) = (f32x4){xf[4], xf[5], xf[6], xf[7]}; } } }
#define HG_FLUSH(cc) { if (stid < 128) { const int s_ = stid >> 2, pc = stid & 3; \
        *(u32x4*)(MIX + ((size_t)b * SEQ + (size_t)(cc) * 32 + s_) * 1024 + hh * 128 + cgp * 32 + pc * 8) = *(const LAS u32x4*)(soutb + ((cc) & 1) * 1024 + s_ * 32 + pc * 8); } }
#define HG_REC(buf, s_lo, cc) { const LAS float* sq_ = (const LAS float*)(stg + (buf) * STB); const LAS float* sf_ = sq_ + 32 * 128; const LAS float* sv_ = sf_ + 32 * 128; LAS bf16_t* so_ = soutb + ((cc) & 1) * 1024; \
        f32x4 cf[4], cq[4]; \
        _Pragma("unroll") for (int i = 0; i < 4; ++i) { cf[i] = *(const LAS f32x4*)(sf_ + (s_lo) * 128 + rq + 32 * i); cq[i] = *(const LAS f32x4*)(sq_ + (s_lo) * 128 + rq + 32 * i); } \
        float cv = sv_[(s_lo) * 32 + col]; \
        _Pragma("unroll 1") for (int g = 0; g < 2; ++g) { float oacc = 0.f; \
            _Pragma("unroll") for (int u = 0; u < 8; ++u) { const int sn = (s_lo) + g * 8 + u + 1; \
                f32x4 nf[4], nq[4]; \
                _Pragma("unroll") for (int i = 0; i < 4; ++i) { nf[i] = *(const LAS f32x4*)(sf_ + sn * 128 + rq + 32 * i); nq[i] = *(const LAS f32x4*)(sq_ + sn * 128 + rq + 32 * i); } \
                const float nv = sv_[sn * 32 + col]; \
                _Pragma("unroll") for (int i = 0; i < 4; ++i) S4[i] = cf[i] * (S4[i] - cv) + cv; \
                f32x2 b2 = cq[0].xy * S4[0].xy, c2 = cq[0].zw * S4[0].zw; b2 += cq[1].xy * S4[1].xy; c2 += cq[1].zw * S4[1].zw; b2 += cq[2].xy * S4[2].xy; c2 += cq[2].zw * S4[2].zw; b2 += cq[3].xy * S4[3].xy; c2 += cq[3].zw * S4[3].zw; b2 += c2; \
                float po = b2[0] + b2[1]; po = rowsum8(po); \
                oacc = (l8 == u) ? po : oacc; \
                _Pragma("unroll") for (int i = 0; i < 4; ++i) { cf[i] = nf[i]; cq[i] = nq[i]; } \
                cv = nv; \
                __builtin_amdgcn_sched_barrier(0); } \
            so_[((s_lo) + g * 8 + l8) * 32 + col] = f2bf(oacc); } }
    const int col = (wid & 3) * 8 + (lane >> 3), rq = (lane & 7) * 4, l8 = lane & 7;
    if (stager) { HG_LOAD(0) HG_TRANSFORM(0) HG_LOAD(1) } else __builtin_amdgcn_s_setprio(2);
    __syncthreads();
#pragma unroll 1
    for (int c = 0; c < NC; ++c) {
        if (stager) { if (c > 0) HG_FLUSH(c - 1) }
        else HG_REC(c & 1, 0, c)
        __syncthreads();
        if (stager) { if (c + 1 < NC) HG_TRANSFORM((c + 1) & 1) if (c + 2 < NC) HG_LOAD(c + 2) }
        else HG_REC(c & 1, 16, c)
        __syncthreads();
    }
    if (stager) HG_FLUSH(NC - 1) else __builtin_amdgcn_s_setprio(0);
#undef HG_LOAD
#undef HG_TRANSFORM
#undef HG_FLUSH
#undef HG_REC
    __syncthreads();
}

__device__ __forceinline__ void ph_rwkv(const Params& P, int j, int task, LAS unsigned char* lds, int tid) {
    const int lane = tid & 63, wid = tid >> 6, il = lane & 15;
    const int bh = task >> 1, b = bh >> 3, hh = bh & 7, half = task & 1;
    const bf16_t* Z = (const bf16_t*)(PWS() + OFF_Z); const bf16_t* HB = (const bf16_t*)((unsigned char*)tabptr(41)); bf16_t* EXT = (bf16_t*)(PWS() + OFF_EXT);
    constexpr int NC = SEQ / 32, STB = 45312;
    LAS bf16_t* raw1 = (LAS bf16_t*)lds;
    LAS bf16_t* raw2 = (LAS bf16_t*)(lds + 10752);
    LAS unsigned char* stg = lds + 18944; LAS bf16_t* soutb = (LAS bf16_t*)(lds + 18944 + 2 * STB);
    const bool stager = wid >= 4; const int stid = tid - 256;
    const int j0 = il * 4, v4 = (stid & 7) * 4;
    float mur[4], muk[4], muv[4], kkw[4], kaw[4], w0v[4], a0v[4];
#pragma unroll
    for (int q = 0; q < 4; ++q) { mur[q] = PIN(22)[(size_t)j * 1792 + hh * 64 + j0 + q]; muk[q] = PIN(22)[(size_t)j * 1792 + 512 + hh * 64 + j0 + q];
        muv[q] = PIN(22)[(size_t)j * 1792 + 1024 + hh * 64 + half * 32 + v4 + q]; kkw[q] = PIN(28)[j * 512 + hh * 64 + j0 + q]; kaw[q] = PIN(29)[j * 512 + hh * 64 + j0 + q];
        w0v[q] = PIN(23)[j * 512 + hh * 64 + j0 + q]; a0v[q] = PIN(25)[j * 512 + hh * 64 + j0 + q]; }
    f32x4 S4[2] = {(f32x4){0.f, 0.f, 0.f, 0.f}, (f32x4){0.f, 0.f, 0.f, 0.f}};
    u32x4 R[5];
    const u32x4 zero4 = zero_u4();
#define R7_LOAD(cc) { const size_t t0_ = (size_t)b * SEQ + (size_t)(cc) * 32; _Pragma("unroll") for (int i = 0; i < 5; ++i) { const int p = stid + 256 * i; u32x4 val = zero4; \
        if (p < 660) { const int rr = p / 20, pc = p - rr * 20; if ((cc) * 32 - 1 + rr >= 0) { \
            const int col = pc < 8 ? (2048 + hh * 64 + pc * 8) : (pc < 16 ? (2560 + hh * 64 + (pc - 8) * 8) : (3072 + hh * 64 + half * 32 + (pc - 16) * 8)); \
            val = *(const u32x4*)(Z + (t0_ - 1 + rr) * ODN + col); } } \
        else if (p < 1172) { const int p2 = p - 660, rr = p2 >> 4, pc = p2 & 15; \
            val = *(const u32x4*)(HB + (t0_ + rr) * 1024 + (pc < 8 ? (hh * 64 + pc * 8) : (512 + hh * 64 + (pc - 8) * 8))); } \
        R[i] = val; } }
#define R7_STORE_RAW() { _Pragma("unroll") for (int i = 0; i < 5; ++i) { const int p = stid + 256 * i; \
        if (p < 660) { const int rr = p / 20, pc = p - rr * 20; *(LAS u32x4*)(raw1 + rr * 160 + pc * 8) = R[i]; } \
        else if (p < 1172) { const int p2 = p - 660, rr = p2 >> 4, pc = p2 & 15; *(LAS u32x4*)(raw2 + rr * 128 + pc * 8) = R[i]; } } }
#define R7_TRANSFORM(buf) { LAS float* sr_ = (LAS float*)(stg + (buf) * STB); LAS float* skp_ = sr_ + 2048; LAS float* snk_ = skp_ + 2048; LAS float* sbb_ = snk_ + 2048; LAS float* sw_ = sbb_ + 2048; LAS float* sv_ = sw_ + 2048; \
        _Pragma("unroll 1") for (int it = 0; it < 2; ++it) { const int tok = it * 16 + (stid >> 4); \
            float rc[4], rp[4], kc[4], kp_[4], lw[4], av[4]; \
            unpack4(*(const LAS u32x2*)(raw1 + (tok + 1) * 160 + j0), rc); unpack4(*(const LAS u32x2*)(raw1 + tok * 160 + j0), rp); \
            unpack4(*(const LAS u32x2*)(raw1 + (tok + 1) * 160 + 64 + j0), kc); unpack4(*(const LAS u32x2*)(raw1 + tok * 160 + 64 + j0), kp_); \
            unpack4(*(const LAS u32x2*)(raw2 + tok * 128 + j0), lw); unpack4(*(const LAS u32x2*)(raw2 + tok * 128 + 64 + j0), av); \
            float r[4], k[4], kk[4], ss = 0.f; \
            _Pragma("unroll") for (int q = 0; q < 4; ++q) { av[q] = sigmoidf_(av[q] + a0v[q]); lw[q] = -0.6065306597126334f * sigmoidf_(lw[q] + w0v[q]); r[q] = rc[q] + mur[q] * (rp[q] - rc[q]); k[q] = kc[q] + muk[q] * (kp_[q] - kc[q]); kk[q] = k[q] * kkw[q]; ss += kk[q] * kk[q]; } \
            ss = rowsum16(ss); const float sc = rsqrtf(ss + 1e-6f); \
            f32x4 o_r, o_kp, o_nk, o_bb, o_w; \
            _Pragma("unroll") for (int q = 0; q < 4; ++q) { const float kn = kk[q] * sc; o_r[q] = r[q]; o_kp[q] = k[q] * (1.0f + (av[q] - 1.0f) * kaw[q]); o_nk[q] = -kn; o_bb[q] = kn * av[q]; o_w[q] = __expf(lw[q]); } \
            *(LAS f32x4*)(sr_ + tok * 64 + j0) = o_r; *(LAS f32x4*)(skp_ + tok * 64 + j0) = o_kp; *(LAS f32x4*)(snk_ + tok * 64 + j0) = o_nk; *(LAS f32x4*)(sbb_ + tok * 64 + j0) = o_bb; *(LAS f32x4*)(sw_ + tok * 64 + j0) = o_w; } \
        { const int tok = stid >> 3; float vc[4], vp[4]; unpack4(*(const LAS u32x2*)(raw1 + (tok + 1) * 160 + 128 + v4), vc); unpack4(*(const LAS u32x2*)(raw1 + tok * 160 + 128 + v4), vp); \
          f32x4 o_v; \
          _Pragma("unroll") for (int q = 0; q < 4; ++q) o_v[q] = vc[q] + muv[q] * (vp[q] - vc[q]); \
          *(LAS f32x4*)(sv_ + tok * 32 + v4) = o_v; } }
#define R7_FLUSH(cc) { if (stid < 128) { const int s_ = stid >> 2, pc = stid & 3; \
        *(u32x4*)(EXT + ((size_t)b * SEQ + (size_t)(cc) * 32 + s_) * 512 + hh * 64 + half * 32 + pc * 8) = *(const LAS u32x4*)(soutb + ((cc) & 1) * 1024 + s_ * 32 + pc * 8); } }
#define R7_REC(buf, s_lo, cc) { const LAS float* sr_ = (const LAS float*)(stg + (buf) * STB); const LAS float* skp_ = sr_ + 2048; const LAS float* snk_ = skp_ + 2048; const LAS float* sbb_ = snk_ + 2048; const LAS float* sw_ = sbb_ + 2048; const LAS float* sv_ = sw_ + 2048; \
        LAS bf16_t* so_ = soutb + ((cc) & 1) * 1024; \
        f32x4 cr[2], ck[2], cn[2], cb[2], cw[2], pr[2]; \
        _Pragma("unroll") for (int i = 0; i < 2; ++i) { cr[i] = *(const LAS f32x4*)(sr_ + (s_lo) * 64 + c8 + 4 * i); ck[i] = *(const LAS f32x4*)(skp_ + (s_lo) * 64 + c8 + 4 * i); cn[i] = *(const LAS f32x4*)(snk_ + (s_lo) * 64 + c8 + 4 * i); \
            cb[i] = *(const LAS f32x4*)(sbb_ + (s_lo) * 64 + c8 + 4 * i); cw[i] = *(const LAS f32x4*)(sw_ + (s_lo) * 64 + c8 + 4 * i); pr[i] = cr[i]; } \
        float cv = sv_[(s_lo) * 32 + row], oacc = 0.f; \
        _Pragma("unroll 1") for (int g = 0; g < 2; ++g) { \
            _Pragma("unroll") for (int u = 0; u < 8; ++u) { const int sn = (s_lo) + g * 8 + u + 1; \
                f32x4 nr[2], nk[2], nn[2], nb[2], nw[2]; \
                _Pragma("unroll") for (int i = 0; i < 2; ++i) { nr[i] = *(const LAS f32x4*)(sr_ + sn * 64 + c8 + 4 * i); nk[i] = *(const LAS f32x4*)(skp_ + sn * 64 + c8 + 4 * i); nn[i] = *(const LAS f32x4*)(snk_ + sn * 64 + c8 + 4 * i); \
                    nb[i] = *(const LAS f32x4*)(sbb_ + sn * 64 + c8 + 4 * i); nw[i] = *(const LAS f32x4*)(sw_ + sn * 64 + c8 + 4 * i); } \
                const float nv = sv_[sn * 32 + row]; \
                  \
                f32x2 a2 = S4[0].xy * cn[0].xy, b2 = S4[0].xy * pr[0].xy; a2 += S4[0].zw * cn[0].zw; b2 += S4[0].zw * pr[0].zw; a2 += S4[1].xy * cn[1].xy; b2 += S4[1].xy * pr[1].xy; a2 += S4[1].zw * cn[1].zw; b2 += S4[1].zw * pr[1].zw;     \
                float sa = a2[0] + a2[1], yp = b2[0] + b2[1]; \
                sa += dppf<0xB1>(sa); yp += dppf<0xB1>(yp); sa += dppf<0x4E>(sa); yp += dppf<0x4E>(yp); sa += dppf<0x141>(sa); yp += dppf<0x141>(yp); \
                if (u == 0) { if (g > 0) { oacc = (l8 == 7) ? yp : oacc; so_[((s_lo) + (g - 1) * 8 + l8) * 32 + row] = f2bf(oacc); } } \
                else oacc = (l8 == u - 1) ? yp : oacc; \
                _Pragma("unroll") for (int i = 0; i < 2; ++i) S4[i] = S4[i] * cw[i] + cb[i] * sa + ck[i] * cv; \
                _Pragma("unroll") for (int i = 0; i < 2; ++i) { pr[i] = cr[i]; cr[i] = nr[i]; ck[i] = nk[i]; cn[i] = nn[i]; cb[i] = nb[i]; cw[i] = nw[i]; } \
                cv = nv; \
                __builtin_amdgcn_sched_barrier(0); } } \
        { f32x2 b2 = S4[0].xy * pr[0].xy; b2 += S4[0].zw * pr[0].zw; b2 += S4[1].xy * pr[1].xy; b2 += S4[1].zw * pr[1].zw; float yp = b2[0] + b2[1]; yp = rowsum8(yp); \
          oacc = (l8 == 7) ? yp : oacc; so_[((s_lo) + 8 + l8) * 32 + row] = f2bf(oacc); } }
    const int row = (wid & 3) * 8 + (lane >> 3), c8 = (lane & 7) * 8, l8 = lane & 7;
    if (stager) R7_LOAD(0) else __builtin_amdgcn_s_setprio(2);
    if (stager) R7_STORE_RAW()
    __syncthreads();
    if (stager) { R7_TRANSFORM(0) R7_LOAD(1) }
    __syncthreads();
#pragma unroll 1
    for (int c = 0; c < NC; ++c) {
        if (stager) { if (c + 1 < NC) R7_STORE_RAW() if (c > 0) R7_FLUSH(c - 1) }
        else R7_REC(c & 1, 0, c)
        __syncthreads();
        if (stager) { if (c + 1 < NC) R7_TRANSFORM((c + 1) & 1) if (c + 2 < NC) R7_LOAD(c + 2) }
        else R7_REC(c & 1, 16, c)
        __syncthreads();
    }
    if (stager) R7_FLUSH(NC - 1) else __builtin_amdgcn_s_setprio(0);
#undef R7_LOAD
#undef R7_STORE_RAW
#undef R7_TRANSFORM
#undef R7_FLUSH
#undef R7_REC
    __syncthreads();
}

__device__ __forceinline__ void ph_odd_post(const Params& P, int j, int tid) {
    const int lane = tid & 63, gw = blockIdx.x * 8 + (tid >> 6), NGW = gridDim.x * 8;
    const bf16_t* Z = (const bf16_t*)(PWS() + OFF_Z); const bf16_t* HB = (const bf16_t*)((unsigned char*)tabptr(41)); const bf16_t* EXT = (const bf16_t*)(PWS() + OFF_EXT); bf16_t* MIX = (bf16_t*)((unsigned char*)tabptr(42));
    const int c0 = lane * 8;
    float nw[8], lnw[8], lnb[8], mur[8], muk[8], muv[8], kaw[8], rk[8], a0v[8];
#define LD8(dst, ptr) { const f32x4 x0_ = *(const f32x4*)(ptr), x1_ = *(const f32x4*)((ptr) + 4); dst[0] = x0_[0]; dst[1] = x0_[1]; dst[2] = x0_[2]; dst[3] = x0_[3]; dst[4] = x1_[0]; dst[5] = x1_[1]; dst[6] = x1_[2]; dst[7] = x1_[3]; }
    LD8(nw, PIN(21) + j * 512 + c0) LD8(lnw, PIN(31) + j * 512 + c0) LD8(lnb, PIN(32) + j * 512 + c0)
    LD8(mur, PIN(22) + (size_t)j * 1792 + c0) LD8(muk, PIN(22) + (size_t)j * 1792 + 512 + c0) LD8(muv, PIN(22) + (size_t)j * 1792 + 1024 + c0)
    LD8(kaw, PIN(29) + j * 512 + c0) LD8(rk, PIN(30) + j * 512 + c0) LD8(a0v, PIN(25) + j * 512 + c0)
#undef LD8
#define OP_LOAD(W, t_) { const size_t zr_ = (size_t)(t_) * ODN; const bf16_t* mp_ = MIX + (size_t)(t_) * 1024; \
        W[0] = *(const u32x4*)(mp_ + c0); W[1] = *(const u32x4*)(Z + zr_ + 1536 + c0); W[2] = *(const u32x4*)(EXT + (size_t)(t_) * 512 + c0); \
        W[3] = *(const u32x4*)(Z + zr_ + 2048 + c0); W[4] = *(const u32x4*)(Z + zr_ + 2560 + c0); W[5] = *(const u32x4*)(Z + zr_ + 3072 + c0); \
        W[6] = *(const u32x4*)(HB + (size_t)(t_) * 1024 + 512 + c0); W[7] = *(const u32x4*)(mp_ + 512 + c0); }
    const int per = (T + NGW - 1) / NGW, tb = gw * per, te = (tb + per < T) ? (tb + per) : T;
    if (tb < te) {
        const u32x4 z4 = zero_u4();
        u32x4 Pr = z4, Pk = z4, Pv = z4, C[8], N[8];
        if ((tb & (SEQ - 1)) != 0) { const size_t zp = (size_t)(tb - 1) * ODN; Pr = *(const u32x4*)(Z + zp + 2048 + c0); Pk = *(const u32x4*)(Z + zp + 2560 + c0); Pv = *(const u32x4*)(Z + zp + 3072 + c0); }
        OP_LOAD(C, tb)
#pragma unroll 1
        for (int t = tb; t < te; ++t) {
            if (t + 1 < te) OP_LOAD(N, t + 1) else {
#pragma unroll
                for (int q = 0; q < 8; ++q) N[q] = z4; }
            bf16_t* mp = MIX + (size_t)t * 1024;
            if ((t & (SEQ - 1)) == 0) { Pr = z4; Pk = z4; Pv = z4; }
            { float o[8], g[8]; unpack8(C[0], o); unpack8(C[1], g);
              float ss = 0.f;
#pragma unroll
              for (int q = 0; q < 8; ++q) ss += o[q] * o[q];
              ss = wave_sum(ss); const float rs = rsqrtf(ss * (1.0f / 512.0f) + 1e-6f);
#pragma unroll
              for (int q = 0; q < 8; ++q) o[q] = o[q] * rs * nw[q] * sigmoidf_(g[q]);
              *(u32x4*)(mp + c0) = pack8(o); }
            { float y[8], rc[8], kc[8], vc[8], rp[8], kp[8], vp[8], av[8], gt[8];
              unpack8(C[2], y); unpack8(C[3], rc); unpack8(C[4], kc); unpack8(C[5], vc); unpack8(Pr, rp); unpack8(Pk, kp); unpack8(Pv, vp); unpack8(C[6], av); unpack8(C[7], gt);
              float sy = 0.f, dot = 0.f;
#pragma unroll
              for (int q = 0; q < 8; ++q) { av[q] = sigmoidf_(av[q] + a0v[q]); sy += y[q]; const float r = rc[q] + mur[q] * (rp[q] - rc[q]); const float k = kc[q] + muk[q] * (kp[q] - kc[q]); vc[q] = vc[q] + muv[q] * (vp[q] - vc[q]);
                  dot += r * (k * (1.0f + (av[q] - 1.0f) * kaw[q])) * rk[q]; }
              sy = rowsum8(sy); dot = rowsum8(dot); const float mean = sy * (1.0f / 64.0f);
              float sv2 = 0.f;
#pragma unroll
              for (int q = 0; q < 8; ++q) { y[q] -= mean; sv2 += y[q] * y[q]; }
              sv2 = rowsum8(sv2); const float rstd = rsqrtf(sv2 * (1.0f / 64.0f) + 64e-5f);
              float o[8];
#pragma unroll
              for (int q = 0; q < 8; ++q) o[q] = (y[q] * rstd * lnw[q] + lnb[q] + dot * vc[q]) * gt[q];
              *(u32x4*)(mp + 512 + c0) = pack8(o); }
            Pr = C[3]; Pk = C[4]; Pv = C[5];
#pragma unroll
            for (int q = 0; q < 8; ++q) C[q] = N[q];
        }
    }
#undef OP_LOAD
}

__device__ __forceinline__ int ltid() { int t = threadIdx.x; asm volatile("" : "+v"(t)); return t; }
__device__ __forceinline__ void grid_bar() {
    XcdBarrier b; b.bar = (unsigned*)(PWS() + OFF_BAR); b.x = xb_xcc_id(); b.st = (volatile LAS unsigned*)((LAS unsigned char*)smem_g + TAB_OFF + 448);
    xcd_barrier(b);
}
template <class Epi>
__device__ __forceinline__ void run_gemm(LAS unsigned char* lds, const bf16_t* A, const bf16_t* Bt, int N, int K, const Epi& E) {
    pg8::Gemm g; g.A = A; g.Bt = Bt; g.M = T; g.N = N; g.K = K;
    pg8::StaticOrder so; so.init(T, N, (int)gridDim.x, (int)blockIdx.x);
    pg8::gemm_phase<Epi, pg8::StaticOrder, false>(lds, g, so, E, nullptr);
}
template <class Epi>
__device__ __forceinline__ void run_gemm_rs(LAS unsigned char* lds, const bf16_t* A, const bf16_t* Bt, int N, int K, const Epi& E, const float* ss) {
    pg8::StaticOrder so; so.init(T, N, (int)gridDim.x, (int)blockIdx.x);
    { const int tid = ltid(); LAS float* rst = (LAS float*)(lds + RS_OFF); Unit u;
      for (int i = tid >> 8; so.next(i, u); i += 2) { const int r = tid & 255; rst[i * 256 + r] = rsqrtf(rowss(ss, u.pm * 256 + r) * (1.0f / 1024.0f) + 1e-6f); }
      __syncthreads(); }
    pg8::Gemm g; g.A = A; g.Bt = Bt; g.M = T; g.N = N; g.K = K;
    pg8::gemm_phase<Epi, pg8::StaticOrder, false>(lds, g, so, E, nullptr);
}

__global__ void __launch_bounds__(512, 2) trunk_fwd(Params P) {
    LAS unsigned char* lds = (LAS unsigned char*)smem_g;
    if (threadIdx.x == 0) { LAS unsigned long long* t = (LAS unsigned long long*)(lds + TAB_OFF);
        t[0] = (unsigned long long)(uintptr_t)P.in[0];
        t[1] = (unsigned long long)(uintptr_t)P.in[1];
        t[2] = (unsigned long long)(uintptr_t)P.in[2];
        t[3] = (unsigned long long)(uintptr_t)P.in[3];
        t[4] = (unsigned long long)(uintptr_t)P.in[4];
        t[5] = (unsigned long long)(uintptr_t)P.in[5];
        t[6] = (unsigned long long)(uintptr_t)P.in[6];
        t[7] = (unsigned long long)(uintptr_t)P.in[7];
        t[8] = (unsigned long long)(uintptr_t)P.in[8];
        t[9] = (unsigned long long)(uintptr_t)P.in[9];
        t[10] = (unsigned long long)(uintptr_t)P.in[10];
        t[11] = (unsigned long long)(uintptr_t)P.in[11];
        t[12] = (unsigned long long)(uintptr_t)P.in[12];
        t[13] = (unsigned long long)(uintptr_t)P.in[13];
        t[14] = (unsigned long long)(uintptr_t)P.in[14];
        t[15] = (unsigned long long)(uintptr_t)P.in[15];
        t[16] = (unsigned long long)(uintptr_t)P.in[16];
        t[17] = (unsigned long long)(uintptr_t)P.in[17];
        t[18] = (unsigned long long)(uintptr_t)P.in[18];
        t[19] = (unsigned long long)(uintptr_t)P.in[19];
        t[20] = (unsigned long long)(uintptr_t)P.in[20];
        t[21] = (unsigned long long)(uintptr_t)P.in[21];
        t[22] = (unsigned long long)(uintptr_t)P.in[22];
        t[23] = (unsigned long long)(uintptr_t)P.in[23];
        t[24] = (unsigned long long)(uintptr_t)P.in[24];
        t[25] = (unsigned long long)(uintptr_t)P.in[25];
        t[26] = (unsigned long long)(uintptr_t)P.in[26];
        t[27] = (unsigned long long)(uintptr_t)P.in[27];
        t[28] = (unsigned long long)(uintptr_t)P.in[28];
        t[29] = (unsigned long long)(uintptr_t)P.in[29];
        t[30] = (unsigned long long)(uintptr_t)P.in[30];
        t[31] = (unsigned long long)(uintptr_t)P.in[31];
        t[32] = (unsigned long long)(uintptr_t)P.in[32];
        t[33] = (unsigned long long)(uintptr_t)P.in[33];
        t[34] = (unsigned long long)(uintptr_t)P.in[34];
        t[35] = (unsigned long long)(uintptr_t)P.in[35];
        t[36] = (unsigned long long)(uintptr_t)P.in[36];
        t[37] = (unsigned long long)(uintptr_t)P.in[37];
        t[38] = (unsigned long long)(uintptr_t)P.in[38];
        t[39] = (unsigned long long)(uintptr_t)P.ws; t[40] = (unsigned long long)(uintptr_t)P.out;
        volatile LAS unsigned* st = (volatile LAS unsigned*)(lds + TAB_OFF + 448); st[0] = 0u; st[1] = 0u; }
    __syncthreads();
    (void)xcd_barrier_post((unsigned*)(P.ws + OFF_BAR), (volatile LAS unsigned*)(lds + TAB_OFF + 448));
    cg::grid_group grid = cg::this_grid();
#define ws PWS()
#define Zb ((bf16_t*)(ws + OFF_Z))
#define HB ((bf16_t*)tabptr(43))
#define HOTH ((bf16_t*)tabptr(44))
#define MIX ((bf16_t*)tabptr(42))
#define ACT ((bf16_t*)(ws + OFF_ACT))
#define UP ((bf16_t*)(ws + OFF_UP))
#define PB ((bf16_t*)(ws + OFF_PB))
#define LAo ((bf16_t*)(ws + OFF_LA))
#define ssA ((float*)(ws + OFF_SS))
#define ssB ((float*)(ws + OFF_SS) + 16 * T)
#define ssC ((float*)(ws + OFF_SS) + 32 * T)

    ph_convert(P, 0, lds, ltid());
    ph_prologue(P, ltid());
    grid.sync();

#pragma unroll 1
    for (int L = 0; L < 4; ++L) {
        const int j = L >> 1; const bool odd = (L & 1) != 0;
#define j lsg(L >> 1)
#define Wb ((const bf16_t*)(ws + OFF_W) + (odd ? WO_BASE : 0))
#define hin HB
        if (threadIdx.x == 0) { LAS unsigned long long* t = (LAS unsigned long long*)(lds + TAB_OFF);
            const unsigned long long h0 = (unsigned long long)(uintptr_t)(PWS() + OFF_HB), h1 = (unsigned long long)(uintptr_t)POUT(), mx = h1 + (unsigned long long)T * 1024 * 2;
            t[43] = odd ? h1 : h0; t[44] = odd ? h0 : h1; t[41] = odd ? h0 : h1; t[42] = mx; }
        __syncthreads();
        if (!odd) { EpiZ e; e.Z = Zb; e.ldc = EVN; e.ss = ssA; run_gemm_rs(lds, hin, Wb + WE_IN, EVN, 1024, e, ssA); }
        else      { EpiZ e; e.Z = Zb; e.ldc = ODN; e.ss = ssA; run_gemm_rs(lds, hin, Wb + WO_IN, ODN, 1024, e, ssA); }
        grid_bar();
#ifndef NO_EVEN
        if (!odd) {
            if (L + 1 < 4) ph_convert(P, L + 1, lds, ltid());
            ph_convert_p(P, L, ltid());
            __syncthreads();
            ph_rg_prep(P, j, lds, ltid());
            ph_gdn_prep(P, j, ltid());
            grid_bar();
            for (int task = blockIdx.x; task < 512; task += gridDim.x) { if (task < 256) ph_gdn(P, j, task, lds, ltid()); else ph_rg_scan(P, task - 256, lds, ltid()); }
            grid_bar();
            ph_gdn_post(P, j, ltid());
            grid_bar();
        }
#endif
#ifndef NO_ODD
        if (odd) {
            if (L + 1 < 4) ph_convert(P, L + 1, lds, ltid());
            ph_convert_p(P, L, ltid());
            ph_lora_prep(P, j, ltid());
            grid_bar();
            { EpiLora e; e.HBp = HOTH; e.MIXp = MIX; run_gemm(lds, LAo, Wb + WO_LORA, 1536, 256, e); }
            grid_bar();
            for (int task = blockIdx.x; task < 256; task += gridDim.x) { if (task < 128) ph_hgrn(P, j, task, lds, ltid()); else ph_rwkv(P, j, task - 128, lds, ltid()); }
            grid_bar();
            ph_odd_post(P, j, ltid());
            grid_bar();
        }
#endif
        { EpiRes e; e.Hp = HB; e.ssn = ssB; run_gemm(lds, MIX, Wb + (odd ? WO_OUT : WE_OUT), 1024, 1024, e); }
        grid_bar();
        { EpiGU e; e.ACTp = ACT; e.ss = ssB; run_gemm_rs(lds, HB, Wb + (odd ? WO_GU : WE_GU), 5632, 1024, e, ssB); }
        { EpiUp e; e.O = UP; run_gemm(lds, PB, Wb + (odd ? WO_PU : WE_PU), 1024, 256, e); }
        grid_bar();
        { EpiRes e; e.Hp = HB; e.ssn = ssC; run_gemm(lds, ACT, Wb + (odd ? WO_DN : WE_DN), 1024, 2816, e); }
        grid_bar();
        { EpiPle e; e.Hin = HB; e.Hout = HOTH; e.ssn = ssA; e.ss = ssC; e.UPp = UP; run_gemm_rs(lds, HB, Wb + (odd ? WO_PG : WE_PG), 1024, 1024, e, ssC); }
        grid_bar();
    }
#undef j
#undef Wb
#undef hin
    ph_final(P, ltid());
}

#undef ws
#undef Zb
#undef HB
#undef HOTH
#undef MIX
#undef ACT
#undef UP
#undef PB
#undef LAo
#undef ssA
#undef ssB
#undef ssC
extern "C" void kernel_launch(void* const* d_in, const int* in_sizes, int n_in, void* d_out, int out_size, void* d_ws, size_t ws_size, hipStream_t stream) {
    static int grid_blocks = 0;
    if (grid_blocks == 0) {
        if (n_in != 39 || out_size != T * DM || ws_size < WS_END) { fprintf(stderr, "kernel_launch: unexpected shapes: n_in %d out %d ws %zu (need %zu)\n", n_in, out_size, ws_size, (size_t)WS_END); grid_blocks = -1; return; }
        int dev = 0, cus = 0, per_cu = 0;
        hipGetDevice(&dev);
        hipDeviceGetAttribute(&cus, hipDeviceAttributeMultiprocessorCount, dev);
        if (hipFuncSetAttribute((const void*)trunk_fwd, hipFuncAttributeMaxDynamicSharedMemorySize, LDS_BYTES) != hipSuccess) { fprintf(stderr, "kernel_launch: hipFuncSetAttribute failed\n"); grid_blocks = -1; return; }
        if (hipOccupancyMaxActiveBlocksPerMultiprocessor(&per_cu, (const void*)trunk_fwd, 512, LDS_BYTES) != hipSuccess || per_cu < 1) { fprintf(stderr, "kernel_launch: occupancy query says %d\n", per_cu); per_cu = 1; }
        (void)hipGetLastError();
        grid_blocks = cus;
        fprintf(stderr, "kernel_launch: grid %d (per_cu %d), ws %zu need %zu\n", grid_blocks, per_cu, ws_size, (size_t)WS_END);
    }
    if (grid_blocks < 0) return;
    Params p{};
    for (int i = 0; i < 39; ++i) p.in[i] = (const float*)d_in[i];
    p.out = (float*)d_out; p.ws = (unsigned char*)d_ws;
    if (hipMemsetAsync((unsigned char*)d_ws + OFF_BAR, 0, 16384, stream) != hipSuccess) { fprintf(stderr, "kernel_launch: memset of the barrier words failed\n"); return; }
    void* args[] = {&p};
    hipError_t e = hipLaunchCooperativeKernel((const void*)trunk_fwd, dim3(grid_blocks), dim3(512), args, LDS_BYTES, stream);
    if (e != hipSuccess) fprintf(stderr, "cooperative launch failed: %s (grid %d)\n", hipGetErrorString(e), grid_blocks);
}
```

```cpp
#include <hip/hip_runtime.h>
#include <hip/hip_cooperative_groups.h>
#include <cstdio>
#include <cstdint>
namespace cg = cooperative_groups;
namespace pg8 {
#define PG8_LAS __attribute__((address_space(3)))
typedef unsigned short bf16_t;
typedef short bf16x8 __attribute__((ext_vector_type(8)));
typedef float f32x4 __attribute__((ext_vector_type(4)));
typedef unsigned u32x4 __attribute__((ext_vector_type(4)));
constexpr int BM = 256, BK = 64, HALF = 128, HTB = HALF * BK * 2  , STAGE_BYTES = 8 * HTB, NXCD = 8, WGM = 8;

__host__ __device__ __forceinline__ int lds_byte(int r, int c) { const int st = (r >> 4) * 2 + (c >> 5), rr = r & 15, cc = c & 31, ob = rr * 64 + cc * 2; return st * 1024 + (ob ^ (((ob >> 9) & 1) << 5)); }
__host__ __device__ __forceinline__ void stage_rc(int b, int& R, int& C) { const int st = b / 1024, sb = b % 1024, swz = sb ^ (((sb >> 9) & 1) << 5); R = (st >> 1) * 16 + swz / 64; C = (st & 1) * 32 + (swz % 64) / 2; }
__host__ __device__ __forceinline__ int perm32(int rho) { const int n = rho >> 4, i = rho & 15; return 8 * (i >> 2) + 4 * n + (i & 3); }

struct Unit { int pm, pn; };
struct Gemm { const bf16_t* A; const bf16_t* Bt; int M, N, K; };

struct StaticOrder {
    int nM, nN, nwg, G, c;
    __host__ __device__ void init(int M, int N, int G_, int c_) { nM = M / BM; nN = N / BM; nwg = nM * nN; G = G_; c = c_; }
    __host__ __device__ bool next(int i, Unit& u) const {
        const long L = (long)i * G + c; if (L >= nwg) return false;
        int wgid = (int)L; { const int q = nwg / NXCD, r = nwg % NXCD, xcd = wgid % NXCD, off = wgid / NXCD; wgid = (xcd < r ? xcd * (q + 1) : r * (q + 1) + (xcd - r) * q) + off; }
        const int nig = WGM * nN, gid = wgid / nig, fm = gid * WGM, gsz = (nM - fm) < WGM ? (nM - fm) : WGM;
        u.pm = fm + ((wgid % nig) % gsz); u.pn = (wgid % nig) / gsz; return true;
    }
    __device__ __forceinline__ void a_ready(const Unit&) const {}
    __device__ __forceinline__ void done(const Unit&) const {}
};
}
namespace pg8 {
__device__ __forceinline__ unsigned cvt_pk_bf16(float lo, float hi) { unsigned r; asm volatile("v_cvt_pk_bf16_f32 %0, %1, %2" : "=v"(r) : "v"(lo), "v"(hi)); return r; }
typedef float f32x2 __attribute__((ext_vector_type(2)));
template <class Epi, class Sched, bool STAMP = false>
__device__ __forceinline__ void gemm_phase(PG8_LAS unsigned char* lds, const Gemm g, const Sched& S, const Epi& E, unsigned long long* stamps) {
    int tid_l = threadIdx.x; asm volatile("" : "+v"(tid_l));
    const int tid = tid_l, wid = __builtin_amdgcn_readfirstlane(tid >> 6), lane = tid & 63, wr = wid >> 2, wc = wid & 3, fr = lane & 15, fq = lane >> 4;
    const int K = g.K, nt = K / BK;
    int ts_lo = 0, ts_hi = 0, nts = 0; const unsigned long long rt_entry = STAMP ? (unsigned long long)wall_clock64() : 0ull;
#define PG8_STAMP() do { if (STAMP && wid == 0 && nts < 64) { const unsigned long long _c = (unsigned long long)clock64(); \
        ts_lo = (lane == nts) ? (int)(unsigned)_c : ts_lo; ts_hi = (lane == nts) ? (int)(unsigned)(_c >> 32) : ts_hi; ++nts; } } while (0)
    PG8_STAMP();
    unsigned voffA[2], voffB[2];
#pragma unroll
    for (int i = 0; i < 2; ++i) { int R, C; stage_rc(tid * 16 + i * 8192, R, C); const int Rb = Epi::PERM ? ((R & ~31) + perm32(R & 31)) : R;
        voffA[i] = (unsigned)(R * K + C) * 2u; voffB[i] = (unsigned)(Rb * K + C) * 2u; }
    const size_t kstep = (size_t)(BK * 2);
    const size_t hstep = (size_t)HALF * K * 2;
    const size_t tstep = 2 * hstep;
    const unsigned ldsw = (unsigned)wid * 1024u;
    const int aoff = lds_byte(wr * 64 + fr, fq * 8), boff = lds_byte(wc * 32 + fr, fq * 8);
#define PG8_SA(b, h) (((b) * 2 + (h)) * HTB)
#define PG8_SB(b, h) ((4 + (b) * 2 + (h)) * HTB)
#define PG8_STAGE(bufoff, gbase, voff) do { _Pragma("unroll") for (int _i = 0; _i < 2; ++_i) \
        __builtin_amdgcn_global_load_lds((const unsigned*)((const char*)(gbase) + (voff)[_i]), (PG8_LAS unsigned*)(lds + (bufoff) + ldsw + _i * 8192), 16, 0, 0); } while (0)
#define PG8_LDA(dst, b, h) do { _Pragma("unroll") for (int m = 0; m < 4; ++m) _Pragma("unroll") for (int k = 0; k < 2; ++k) dst[m][k] = *(const PG8_LAS bf16x8*)(lds + PG8_SA(b, h) + aoff + m * 2048 + k * 1024); } while (0)
#define PG8_LDB(dst, b, h) do { _Pragma("unroll") for (int n = 0; n < 2; ++n) _Pragma("unroll") for (int k = 0; k < 2; ++k) dst[n][k] = *(const PG8_LAS bf16x8*)(lds + PG8_SB(b, h) + boff + n * 2048 + k * 1024); } while (0)
#define PG8_MMA(ai, bj, At, Bt) do { __builtin_amdgcn_s_setprio(1); _Pragma("unroll") for (int m = 0; m < 4; ++m) _Pragma("unroll") for (int n = 0; n < 2; ++n) _Pragma("unroll") for (int k = 0; k < 2; ++k) \
        acc[ai][bj][m][n] = __builtin_amdgcn_mfma_f32_16x16x32_bf16(Bt[n][k], At[m][k], acc[ai][bj][m][n], 0, 0, 0); __builtin_amdgcn_s_setprio(0); } while (0)
#define PG8_WAIT_V(n) asm volatile("s_waitcnt vmcnt(" #n ")" ::: "memory")
#define PG8_WAIT_L(n) asm volatile("s_waitcnt lgkmcnt(" #n ")" ::: "memory")
#define PG8_BAR __builtin_amdgcn_s_barrier()
#define PG8_SCHED __builtin_amdgcn_sched_barrier(0)
    Unit cur, nxt; int ui = 0;
    if (!S.next(0, cur)) return;
    f32x4 acc[2][2][4][2];
#pragma unroll
    for (int a = 0; a < 2; ++a)
#pragma unroll
        for (int b = 0; b < 2; ++b)
#pragma unroll
            for (int m = 0; m < 4; ++m)
#pragma unroll
                for (int n = 0; n < 2; ++n) acc[a][b][m][n] = (f32x4){0.f, 0.f, 0.f, 0.f};
    bf16x8 At[4][2], B0[2][2], B1[2][2];
    const char* cA = (const char*)g.A + (size_t)cur.pm * tstep; const char* cB = (const char*)g.Bt + (size_t)cur.pn * tstep;
    S.a_ready(cur);
    PG8_STAGE(PG8_SB(0, 0), cB, voffB); PG8_STAGE(PG8_SA(0, 0), cA, voffA); PG8_STAGE(PG8_SB(0, 1), cB + hstep, voffB); PG8_STAGE(PG8_SA(0, 1), cA + hstep, voffA);
    if (wr == 1) PG8_BAR;
    PG8_WAIT_V(4); PG8_BAR;
    PG8_STAGE(PG8_SB(1, 0), cB + kstep, voffB); PG8_STAGE(PG8_SA(1, 0), cA + kstep, voffA); PG8_STAGE(PG8_SB(1, 1), cB + hstep + kstep, voffB);
    PG8_WAIT_V(6); PG8_BAR;
    PG8_STAMP();
    for (;;) {
        const bool has_next = S.next(ui + 1, nxt);
        const char* nA = has_next ? (const char*)g.A + (size_t)nxt.pm * tstep : cA; const char* nB = has_next ? (const char*)g.Bt + (size_t)nxt.pn * tstep : cB;
        for (int t = 0; t < nt; t += 2) {
            const bool last = (t == nt - 2);
            const char* a1 = cA + (size_t)(t + 1) * kstep;
            const char* a2 = last ? nA : cA + (size_t)(t + 2) * kstep; const char* b2 = last ? nB : cB + (size_t)(t + 2) * kstep;
            const char* a3 = a2 + kstep; const char* b3 = b2 + kstep;
            if (last && has_next) S.a_ready(nxt);
            PG8_LDB(B0, 0, 0); PG8_SCHED; PG8_LDA(At, 0, 0); PG8_STAGE(PG8_SA(1, 1), a1 + hstep, voffA);
            PG8_WAIT_L(8); PG8_BAR; PG8_WAIT_L(0); PG8_MMA(0, 0, At, B0); PG8_BAR; PG8_SCHED;
            PG8_LDB(B1, 0, 1); PG8_STAGE(PG8_SB(0, 0), b2, voffB);
            PG8_BAR; PG8_WAIT_L(0); PG8_MMA(0, 1, At, B1); PG8_BAR;
            PG8_LDA(At, 0, 1); PG8_STAGE(PG8_SA(0, 0), a2, voffA);
            PG8_BAR; PG8_WAIT_L(0); PG8_MMA(1, 0, At, B0); PG8_BAR; PG8_SCHED;
            PG8_STAGE(PG8_SB(0, 1), b2 + hstep, voffB);
            PG8_WAIT_V(6); PG8_BAR; PG8_MMA(1, 1, At, B1); PG8_BAR;
            PG8_LDB(B0, 1, 0); PG8_SCHED; PG8_LDA(At, 1, 0); PG8_STAGE(PG8_SA(0, 1), a2 + hstep, voffA);
            PG8_WAIT_L(8); PG8_BAR; PG8_WAIT_L(0); PG8_MMA(0, 0, At, B0); PG8_BAR; PG8_SCHED;
            PG8_LDB(B1, 1, 1); PG8_STAGE(PG8_SB(1, 0), b3, voffB);
            PG8_BAR; PG8_WAIT_L(0); PG8_MMA(0, 1, At, B1); PG8_BAR;
            PG8_LDA(At, 1, 1); PG8_STAGE(PG8_SA(1, 0), a3, voffA);
            PG8_BAR; PG8_WAIT_L(0); PG8_MMA(1, 0, At, B0); PG8_BAR; PG8_SCHED;
            PG8_STAGE(PG8_SB(1, 1), b3 + hstep, voffB);
            PG8_WAIT_V(6); PG8_BAR; PG8_MMA(1, 1, At, B1); PG8_BAR;
        }
        PG8_STAMP();
        if constexpr (!Epi::AFTER_DRAIN) { E(acc, cur, wr, wc, fr, fq); S.done(cur); }
        PG8_STAMP();
        if (!has_next) break;
#pragma unroll
        for (int a = 0; a < 2; ++a)
#pragma unroll
            for (int b = 0; b < 2; ++b)
#pragma unroll
                for (int m = 0; m < 4; ++m)
#pragma unroll
                    for (int n = 0; n < 2; ++n) acc[a][b][m][n] = (f32x4){0.f, 0.f, 0.f, 0.f};
        cur = nxt; cA = nA; cB = nB; ++ui;
    }
    PG8_WAIT_V(0);
    if (wr == 0) PG8_BAR;
    PG8_BAR;
    if constexpr (Epi::AFTER_DRAIN) { E.fused(acc, cur, wr, wc, fr, fq, lds, wid, lane); S.done(cur); }
    PG8_STAMP();
    if (STAMP && wid == 0) { stamps[lane] = lane < nts ? (((unsigned long long)(unsigned)ts_hi << 32) | (unsigned)ts_lo) : 0ull;
        if (lane == 62) stamps[62] = rt_entry; if (lane == 63) stamps[63] = (unsigned long long)wall_clock64(); }
#undef PG8_STAMP
#undef PG8_SA
#undef PG8_SB
#undef PG8_STAGE
#undef PG8_LDA
#undef PG8_LDB
#undef PG8_MMA
#undef PG8_WAIT_V
#undef PG8_WAIT_L
#undef PG8_BAR
#undef PG8_SCHED
}
}

using pg8::bf16_t; using pg8::f32x4; using pg8::u32x4; using pg8::bf16x8; using pg8::Unit; using pg8::cvt_pk_bf16;
typedef unsigned u32x2 __attribute__((ext_vector_type(2)));
typedef float f32x2 __attribute__((ext_vector_type(2)));
#define LAS __attribute__((address_space(3)))

constexpr int T = 32768, DM = 1024, FF = 2816, SEQ = 4096;
constexpr int EVN = 3328, ODN = 3840;
constexpr int LDS_BYTES = 147456;
constexpr size_t WE_IN = 0, WE_OUT = WE_IN + (size_t)3328 * 1024, WE_GU = WE_OUT + (size_t)1024 * 1024, WE_DN = WE_GU + (size_t)5632 * 1024,
                 WE_PG = WE_DN + (size_t)1024 * 2816, WE_PU = WE_PG + (size_t)1024 * 1024, WE_END = WE_PU + (size_t)1024 * 256;
constexpr size_t WO_BASE = WE_END;
constexpr size_t WO_IN = 0, WO_LORA = WO_IN + (size_t)3840 * 1024, WO_OUT = WO_LORA + (size_t)1536 * 256, WO_GU = WO_OUT + (size_t)1024 * 1024,
                 WO_DN = WO_GU + (size_t)5632 * 1024, WO_PG = WO_DN + (size_t)1024 * 2816, WO_PU = WO_PG + (size_t)1024 * 1024, WO_END = WO_PU + (size_t)1024 * 256;
constexpr size_t OFF_W = 0;
constexpr size_t OFF_Z = (WE_END + WO_END) * 2;
constexpr size_t OFF_HB = OFF_Z + (size_t)T * 3840 * 2;
constexpr size_t OFF_MIX = OFF_HB + (size_t)T * 1024 * 2;
constexpr size_t OFF_PB = OFF_MIX + (size_t)T * 1024 * 2;
constexpr size_t OFF_LA = OFF_PB + (size_t)T * 256 * 2;
constexpr size_t OFF_EXT = OFF_LA + (size_t)T * 256 * 2;
constexpr size_t OFF_SS = OFF_EXT + (size_t)T * 512 * 2;
constexpr size_t OFF_BAR = OFF_SS + (size_t)3 * T * 16 * 4;
constexpr size_t WS_END = OFF_BAR + 16384;
constexpr size_t OFF_QK = OFF_MIX;
constexpr size_t OFF_ACT = OFF_Z, OFF_UP = OFF_Z + (size_t)T * 2816 * 2;

struct Params { const float* in[39]; float* out; unsigned char* ws; };

__device__ __forceinline__ int lsg(int k) { asm volatile("" : "+s"(k)); return k; }
extern __shared__ __attribute__((aligned(16))) unsigned char smem_g[];
constexpr int TAB_OFF = LDS_BYTES - 512;
constexpr int RS_OFF = 131072;
__device__ __forceinline__ const float* tabptr(int k) { int off = TAB_OFF + 8 * k; asm volatile("" : "+v"(off));
    const LAS unsigned* t = (const LAS unsigned*)((LAS unsigned char*)smem_g + off); unsigned lo = t[0], hi = t[1];
    lo = __builtin_amdgcn_readfirstlane(lo); hi = __builtin_amdgcn_readfirstlane(hi); return (const float*)(const __attribute__((address_space(1))) float*)(((uintptr_t)hi << 32) | (uintptr_t)lo); }
#define PIN(k) tabptr(k)
#define PWS() ((unsigned char*)tabptr(39))
#define POUT() ((float*)tabptr(40))
__device__ __forceinline__ float bflo(unsigned w) { return __uint_as_float(w << 16); }
__device__ __forceinline__ float bfhi(unsigned w) { return __uint_as_float(w & 0xffff0000u); }
__device__ __forceinline__ float bf2f(bf16_t u) { return __uint_as_float(((unsigned)u) << 16); }
__device__ __forceinline__ bf16_t f2bf(float f) { return (bf16_t)(cvt_pk_bf16(f, 0.f) & 0xffffu); }
__device__ __forceinline__ void unpack8(const u32x4 w, float (&f)[8]) { f[0] = bflo(w.x); f[1] = bfhi(w.x); f[2] = bflo(w.y); f[3] = bfhi(w.y); f[4] = bflo(w.z); f[5] = bfhi(w.z); f[6] = bflo(w.w); f[7] = bfhi(w.w); }
__device__ __forceinline__ u32x4 pack8(const float (&f)[8]) { u32x4 w; w.x = cvt_pk_bf16(f[0], f[1]); w.y = cvt_pk_bf16(f[2], f[3]); w.z = cvt_pk_bf16(f[4], f[5]); w.w = cvt_pk_bf16(f[6], f[7]); return w; }
__device__ __forceinline__ void unpack4(const u32x2 w, float (&f)[4]) { f[0] = bflo(w.x); f[1] = bfhi(w.x); f[2] = bflo(w.y); f[3] = bfhi(w.y); }
__device__ __forceinline__ float sigmoidf_(float x) { return __builtin_amdgcn_rcpf(1.0f + __expf(-x)); }
__device__ __forceinline__ float siluf_(float x) { return x * __builtin_amdgcn_rcpf(1.0f + __expf(-x)); }
__device__ __forceinline__ float softplusf_(float x) { return fmaxf(x, 0.f) + log1pf(__expf(-fabsf(x))); }
__device__ __forceinline__ float gelu_tanh(float x) { const float y = 0.7978845608028654f * (x + 0.044715f * x * x * x); const float t = 1.0f - 2.0f * __builtin_amdgcn_rcpf(1.0f + __expf(2.0f * y)); return 0.5f * x * (1.0f + t); }
template <int CTRL> __device__ __forceinline__ float dppf(float v) { return __int_as_float(__builtin_amdgcn_update_dpp(0, __float_as_int(v), CTRL, 0xF, 0xF, true)); }
__device__ __forceinline__ float rowsum16(float v) { v += dppf<0xB1>(v); v += dppf<0x4E>(v); v += dppf<0x141>(v); v += dppf<0x140>(v); return v; }
__device__ __forceinline__ float rowsum8(float v) { v += dppf<0xB1>(v); v += dppf<0x4E>(v); v += dppf<0x141>(v); return v; }
__device__ __forceinline__ float wave_sum(float v) {
    v = rowsum16(v);
    const float a = __int_as_float(__builtin_amdgcn_readlane(__float_as_int(v), 0)), b = __int_as_float(__builtin_amdgcn_readlane(__float_as_int(v), 16)),
                c = __int_as_float(__builtin_amdgcn_readlane(__float_as_int(v), 32)), d = __int_as_float(__builtin_amdgcn_readlane(__float_as_int(v), 48));
    return (a + b) + (c + d);
}
__device__ __forceinline__ float quadsum(float s, int lane) {
    s += __int_as_float(__builtin_amdgcn_ds_bpermute((lane ^ 16) << 2, __float_as_int(s)));
    s += __int_as_float(__builtin_amdgcn_ds_bpermute((lane ^ 32) << 2, __float_as_int(s)));
    return s;
}
__device__ __forceinline__ u32x4 zero_u4() { unsigned z = 0u; asm volatile("" : "+v"(z)); u32x4 r = {z, z, z, z}; return r; }
__device__ __forceinline__ float rowss(const float* ss, int row) {
    const f32x4* p = (const f32x4*)(ss + (size_t)row * 16); const f32x4 a = p[0], b = p[1], c = p[2], d = p[3];
    return (((a[0] + a[1]) + (a[2] + a[3])) + ((b[0] + b[1]) + (b[2] + b[3]))) + (((c[0] + c[1]) + (c[2] + c[3])) + ((d[0] + d[1]) + (d[2] + d[3])));
}
#define LDS_FENCE() asm volatile("s_waitcnt lgkmcnt(0)" ::: "memory")

#define XB_TMO      128
#define XB_XCNT(j)  (256  + 64 * (j))
#define XB_XSUB(j)  (1280 + 64 * (j))
#define XB_XGEN(j)  (2304 + 64 * (j))
#define XB_TOP      3328
#define XB_TOPGEN   3392
#define XCD_BAR_WORDS 3456
#define XB_SPIN_CAP (1u << 22)

__device__ __forceinline__ unsigned xb_ld(unsigned* p)              { return __hip_atomic_load(p, __ATOMIC_RELAXED, __HIP_MEMORY_SCOPE_AGENT); }
__device__ __forceinline__ unsigned xb_add(unsigned* p, unsigned v) { return __hip_atomic_fetch_add(p, v, __ATOMIC_RELAXED, __HIP_MEMORY_SCOPE_AGENT); }
__device__ __forceinline__ unsigned xb_xcc_id() { return (unsigned)__builtin_amdgcn_s_getreg((3 << 11) | 20) & 0xFu; }
#define XB_SPIN(cond, bar) do { unsigned _sp = 0; while (cond) { __builtin_amdgcn_s_sleep(1); \
    if ((++_sp & 255u) == 0u) { if (xb_ld(&(bar)[XB_TMO])) break; if (_sp > XB_SPIN_CAP) { atomicAdd(&(bar)[XB_TMO], 1u); break; } } } } while (0)

struct XcdBarrier {
    unsigned* bar; unsigned x;
    volatile LAS unsigned* st;
};

__device__ __forceinline__ XcdBarrier xcd_barrier_post(unsigned* bar, volatile LAS unsigned* st) {
    XcdBarrier b; b.bar = bar; b.x = xb_xcc_id(); b.st = st;
    if (threadIdx.x == 0) (void)xb_add(&bar[XB_XCNT(b.x)], 1u);
    return b;
}
__device__ __forceinline__ void xcd_barrier_complete(unsigned* bar, unsigned x, unsigned& nloc, unsigned& nx) {
    const unsigned G = gridDim.x * gridDim.y * gridDim.z;
    unsigned sum, cnt, mine, sp = 0u;
    for (;;) {
        sum = 0u; cnt = 0u; mine = 0u;
#pragma unroll
        for (unsigned j = 0; j < 16; ++j) { const unsigned c = xb_ld(&bar[XB_XCNT(j)]); sum += c; cnt += (c > 0u) ? 1u : 0u; mine = (j == x) ? c : mine; }
        if (sum == G) break;
        __builtin_amdgcn_s_sleep(1);
        if ((++sp & 255u) == 0u) { if (xb_ld(&bar[XB_TMO])) break; if (sp > XB_SPIN_CAP) { atomicAdd(&bar[XB_TMO], 1u); break; } }
    }
    nloc = mine > 0u ? mine : 1u; nx = cnt > 0u ? cnt : 1u;
}

__device__ __forceinline__ void xcd_barrier(const XcdBarrier& b) {
    asm volatile("s_waitcnt vmcnt(0)" ::: "memory");
    __syncthreads();
    if (threadIdx.x == 0) {
        unsigned* bar = b.bar;
        __builtin_amdgcn_s_waitcnt(0);
        unsigned nloc = b.st[0], nx = b.st[1];
        if (nloc == 0u) { xcd_barrier_complete(bar, b.x, nloc, nx); b.st[0] = nloc; b.st[1] = nx; }
        const unsigned old = xb_add(&bar[XB_XSUB(b.x)], 1u);
        const unsigned gen = old / nloc;
        if (old + 1u == (gen + 1u) * nloc) {
            __builtin_amdgcn_fence(__ATOMIC_RELEASE, "agent");
            asm volatile("s_waitcnt vmcnt(0)" ::: "memory");
            const unsigned og = xb_add(&bar[XB_TOP], 1u);
            const unsigned tg = og / nx;
            if (og + 1u == (tg + 1u) * nx) xb_add(&bar[XB_TOPGEN], 1u);
            else XB_SPIN(xb_ld(&bar[XB_TOPGEN]) == tg, bar);
            __builtin_amdgcn_fence(__ATOMIC_ACQUIRE, "agent");
            xb_add(&bar[XB_XGEN(b.x)], 1u);
            asm volatile("s_waitcnt vmcnt(0)" ::: "memory");
        } else {
            XB_SPIN(xb_ld(&bar[XB_XGEN(b.x)]) == gen, bar);
            __builtin_amdgcn_fence(__ATOMIC_ACQUIRE, "agent");
            asm volatile("s_waitcnt vmcnt(0)" ::: "memory");
        }
    }
    __syncthreads();
}


__device__ __forceinline__ void st16_wt(void* p, const u32x4 v) { asm volatile("global_store_dwordx4 %0, %1, off sc1\n\ts_nop 1" :: "v"(p), "v"(v) : "memory"); }
struct EpiZ {
    static constexpr bool PERM = true, AFTER_DRAIN = false;
    bf16_t* Z; int ldc; const float* ss; mutable int ui = 0;
    __device__ __forceinline__ void operator()(const f32x4 (&acc)[2][2][4][2], const Unit& u, int wr, int wc, int fr, int fq) const {
        const LAS float* rst = (const LAS float*)((LAS unsigned char*)smem_g + RS_OFF) + ui * 256; ++ui;
        const int row0 = u.pm * 256 + wr * 64 + fr, col0 = u.pn * 256 + wc * 32 + 8 * fq;
#pragma unroll
        for (int ai = 0; ai < 2; ++ai)
#pragma unroll
            for (int m = 0; m < 4; ++m) {
                const int row = row0 + ai * 128 + m * 16; const float rs = rst[ai * 128 + wr * 64 + m * 16 + fr];
                bf16_t* rowp = Z + (size_t)row * ldc + col0;
#pragma unroll
                for (int bj = 0; bj < 2; ++bj) { const f32x4 v0 = acc[ai][bj][m][0] * rs, v1 = acc[ai][bj][m][1] * rs;
                    u32x4 w; w.x = cvt_pk_bf16(v0[0], v0[1]); w.y = cvt_pk_bf16(v0[2], v0[3]); w.z = cvt_pk_bf16(v1[0], v1[1]); w.w = cvt_pk_bf16(v1[2], v1[3]);
                    st16_wt(rowp + bj * 128, w); } }
    }
};
struct EpiRes {
    static constexpr bool PERM = true, AFTER_DRAIN = false;
    bf16_t* Hp; float* ssn;
    __device__ __forceinline__ void operator()(const f32x4 (&acc)[2][2][4][2], const Unit& u, int wr, int wc, int fr, int fq) const {
        const int row0 = u.pm * 256 + wr * 64 + fr, col0 = u.pn * 256 + wc * 32 + 8 * fq;
#pragma unroll
        for (int ai = 0; ai < 2; ++ai) {
            u32x4 hw[4][2];
#pragma unroll
            for (int m = 0; m < 4; ++m)
#pragma unroll
                for (int bj = 0; bj < 2; ++bj) hw[m][bj] = *(const u32x4*)(Hp + (size_t)(row0 + ai * 128 + m * 16) * 1024 + col0 + bj * 128);
#pragma unroll
            for (int m = 0; m < 4; ++m) {
                const int row = row0 + ai * 128 + m * 16; bf16_t* rowp = Hp + (size_t)row * 1024 + col0; float s = 0.f;
#pragma unroll
                for (int bj = 0; bj < 2; ++bj) { float hf[8]; unpack8(hw[m][bj], hf);
#pragma unroll
                    for (int n = 0; n < 2; ++n)
#pragma unroll
                        for (int q = 0; q < 4; ++q) { hf[n * 4 + q] += acc[ai][bj][m][n][q]; s += hf[n * 4 + q] * hf[n * 4 + q]; }
                    st16_wt(rowp + bj * 128, pack8(hf)); }
                s = quadsum(s, fq * 16 + fr);
                if (fq == 0) ssn[(size_t)row * 16 + u.pn * 4 + wc] = s; }
            asm volatile("" ::: "memory"); }
    }
};
struct EpiGU {
    static constexpr bool PERM = true, AFTER_DRAIN = false;
    bf16_t* ACTp; const float* ss; mutable int ui = 0;
    __device__ __forceinline__ void operator()(const f32x4 (&acc)[2][2][4][2], const Unit& u, int wr, int wc, int fr, int fq) const {
        const LAS float* rst = (const LAS float*)((LAS unsigned char*)smem_g + RS_OFF) + ui * 256; ++ui;
        const int row0 = u.pm * 256 + wr * 64 + fr, col0 = u.pn * 128 + wc * 32 + 8 * fq;
#pragma unroll
        for (int ai = 0; ai < 2; ++ai)
#pragma unroll
            for (int m = 0; m < 4; ++m) {
                const int row = row0 + ai * 128 + m * 16; const float rs = rst[ai * 128 + wr * 64 + m * 16 + fr];
                float o[8];
#pragma unroll
                for (int n = 0; n < 2; ++n)
#pragma unroll
                    for (int q = 0; q < 4; ++q) { const float g = acc[ai][0][m][n][q] * rs, up = acc[ai][1][m][n][q] * rs; o[n * 4 + q] = siluf_(g) * up; }
                st16_wt(ACTp + (size_t)row * FF + col0, pack8(o)); }
    }
};
struct EpiPle {
    static constexpr bool PERM = true, AFTER_DRAIN = false;
    const bf16_t* Hin; bf16_t* Hout; float* ssn; const float* ss; const bf16_t* UPp; mutable int ui = 0;
    __device__ __forceinline__ void operator()(const f32x4 (&acc)[2][2][4][2], const Unit& u, int wr, int wc, int fr, int fq) const {
        const LAS float* rst = (const LAS float*)((LAS unsigned char*)smem_g + RS_OFF) + ui * 256; ++ui;
        const int row0 = u.pm * 256 + wr * 64 + fr, col0 = u.pn * 256 + wc * 32 + 8 * fq;
#pragma unroll
        for (int ai = 0; ai < 2; ++ai) {
            u32x4 hw[4][2], uw[4][2];
#pragma unroll
            for (int m = 0; m < 4; ++m)
#pragma unroll
                for (int bj = 0; bj < 2; ++bj) { const size_t off = (size_t)(row0 + ai * 128 + m * 16) * 1024 + col0 + bj * 128; hw[m][bj] = *(const u32x4*)(Hin + off); uw[m][bj] = *(const u32x4*)(UPp + off); }
#pragma unroll
            for (int m = 0; m < 4; ++m) {
                const int row = row0 + ai * 128 + m * 16; const size_t off = (size_t)row * 1024 + col0; float s = 0.f;
                const float rs = rst[ai * 128 + wr * 64 + m * 16 + fr];
#pragma unroll
                for (int bj = 0; bj < 2; ++bj) { float hf[8], uf[8]; unpack8(hw[m][bj], hf); unpack8(uw[m][bj], uf);
#pragma unroll
                    for (int n = 0; n < 2; ++n)
#pragma unroll
                        for (int q = 0; q < 4; ++q) { hf[n * 4 + q] += sigmoidf_(acc[ai][bj][m][n][q] * rs) * uf[n * 4 + q]; s += hf[n * 4 + q] * hf[n * 4 + q]; }
                    st16_wt(Hout + off + bj * 128, pack8(hf)); }
                s = quadsum(s, fq * 16 + fr);
                if (fq == 0) ssn[(size_t)row * 16 + u.pn * 4 + wc] = s; }
            asm volatile("" ::: "memory"); }
    }
};
struct EpiUp {
    static constexpr bool PERM = true, AFTER_DRAIN = false;
    bf16_t* O;
    __device__ __forceinline__ void operator()(const f32x4 (&acc)[2][2][4][2], const Unit& u, int wr, int wc, int fr, int fq) const {
        const int row0 = u.pm * 256 + wr * 64 + fr, col0 = u.pn * 256 + wc * 32 + 8 * fq;
#pragma unroll
        for (int ai = 0; ai < 2; ++ai)
#pragma unroll
            for (int m = 0; m < 4; ++m) {
                bf16_t* rowp = O + (size_t)(row0 + ai * 128 + m * 16) * 1024 + col0;
#pragma unroll
                for (int bj = 0; bj < 2; ++bj) { const f32x4 v0 = acc[ai][bj][m][0], v1 = acc[ai][bj][m][1];
                    u32x4 w; w.x = cvt_pk_bf16(v0[0], v0[1]); w.y = cvt_pk_bf16(v0[2], v0[3]); w.z = cvt_pk_bf16(v1[0], v1[1]); w.w = cvt_pk_bf16(v1[2], v1[3]);
                    st16_wt(rowp + bj * 128, w); } }
    }
};
struct EpiLora {
    static constexpr bool PERM = true, AFTER_DRAIN = false;
    bf16_t* HBp; bf16_t* MIXp;
    __device__ __forceinline__ void operator()(const f32x4 (&acc)[2][2][4][2], const Unit& u, int wr, int wc, int fr, int fq) const {
        const int row0 = u.pm * 256 + wr * 64 + fr; const int kind = u.pn >> 1; const int cc0 = (u.pn & 1) * 256 + wc * 32 + 8 * fq;
        bf16_t* dbase = ((kind == 2) ? (MIXp + 512) : (HBp + (kind == 1 ? 512 : 0))) + cc0;
#pragma unroll
        for (int ai = 0; ai < 2; ++ai)
#pragma unroll
            for (int m = 0; m < 4; ++m) {
                bf16_t* rowp = dbase + (size_t)(row0 + ai * 128 + m * 16) * 1024;
#pragma unroll
                for (int bj = 0; bj < 2; ++bj) { const f32x4 v0 = acc[ai][bj][m][0], v1 = acc[ai][bj][m][1];
                    u32x4 w; w.x = cvt_pk_bf16(v0[0], v0[1]); w.y = cvt_pk_bf16(v0[2], v0[3]); w.z = cvt_pk_bf16(v1[0], v1[1]); w.w = cvt_pk_bf16(v1[2], v1[3]);
                    st16_wt(rowp + bj * 128, w); } }
    }
};

__device__ __forceinline__ int nmap(int n, int mode, int roff) { return mode == 0 ? n + roff : (mode == 1 ? ((n >> 7) * 256 + (n & 127)) : ((n >> 7) * 256 + 128 + (n & 127))); }
__device__ __forceinline__ void tr_item(const float* W, int K, int N, bf16_t* dst, int ldk, int koff, int mode, int roff, const float* ks, LAS float* scr, int item, int lane) {
    const int nblk = (N + 31) >> 5, kb = item / nblk, nb = item - kb * nblk, k0 = 64 * kb, n0 = 32 * nb;
    const int nl = n0 + (lane & 31);
    const int c = lane & 7;
    f32x4 sc0 = {1.f, 1.f, 1.f, 1.f}, sc1 = {1.f, 1.f, 1.f, 1.f};
    if (ks) { sc0 = *(const f32x4*)(ks + k0 + 8 * c); sc1 = *(const f32x4*)(ks + k0 + 8 * c + 4); }
#pragma unroll
    for (int i = 0; i < 32; ++i) { const int kk = 2 * i + (lane >> 5); float v = 0.f;
        if (nl < N) v = W[(size_t)(k0 + kk) * N + nl];
        scr[kk * 33 + (lane & 31)] = v; }
    LDS_FENCE();
#pragma unroll
    for (int j = 0; j < 4; ++j) { const int nn = (lane >> 3) + 8 * j; const LAS float* s = scr + (8 * c) * 33 + nn;
        u32x4 o; o.x = cvt_pk_bf16(s[0 * 33] * sc0[0], s[1 * 33] * sc0[1]); o.y = cvt_pk_bf16(s[2 * 33] * sc0[2], s[3 * 33] * sc0[3]); o.z = cvt_pk_bf16(s[4 * 33] * sc1[0], s[5 * 33] * sc1[1]); o.w = cvt_pk_bf16(s[6 * 33] * sc1[2], s[7 * 33] * sc1[3]);
        if (n0 + nn < N) *(u32x4*)(dst + (size_t)nmap(n0 + nn, mode, roff) * ldk + koff + k0 + 8 * c) = o; }
    LDS_FENCE();
}
__device__ __forceinline__ void ph_convert(const Params& P, int L, LAS unsigned char* lds, int tid) {
    const int lane = tid & 63, wid = tid >> 6;
    const int gw = blockIdx.x * 8 + wid, NGW = gridDim.x * 8, gtid = blockIdx.x * 512 + tid, NTH = gridDim.x * 512;
    LAS float* scr = (LAS float*)(lds + wid * 8704);
    const int j = L >> 1; const bool odd = (L & 1) != 0;
    bf16_t* Wb = (bf16_t*)(PWS() + OFF_W) + (odd ? WO_BASE : 0);
    int it = gw;
#define JOB(Wsrc, K_, N_, dst_, ldk_, koff_, mode_, roff_, ks_) { const int ni = ((K_) / 64) * (((N_) + 31) / 32); \
        for (; it < ni; it += NGW) tr_item((Wsrc), (K_), (N_), (dst_), (ldk_), (koff_), (mode_), (roff_), (ks_), scr, it, lane); it -= ni; }
    if (!odd) {
        JOB(PIN(6) + (size_t)j * 1024 * 3080, 1024, 3080, Wb + WE_IN, 1024, 0, 0, 0, PIN(2) + L * 1024)
        JOB(PIN(18) + (size_t)j * 1024 * 1024, 1024, 1024, Wb + WE_OUT, 1024, 0, 0, 0, (const float*)nullptr)
    } else {
        JOB(PIN(19) + (size_t)j * 1024 * 3840, 1024, 3840, Wb + WO_IN, 1024, 0, 0, 0, PIN(2) + L * 1024)
        JOB(PIN(24) + (size_t)j * 64 * 512, 64, 512, Wb + WO_LORA, 256, 0, 0, 0, (const float*)nullptr)
        JOB(PIN(26) + (size_t)j * 64 * 512, 64, 512, Wb + WO_LORA, 256, 64, 0, 512, (const float*)nullptr)
        JOB(PIN(27) + (size_t)j * 128 * 512, 128, 512, Wb + WO_LORA, 256, 128, 0, 1024, (const float*)nullptr)
        JOB(PIN(33) + (size_t)j * 1024 * 1024, 1024, 1024, Wb + WO_OUT, 1024, 0, 0, 0, (const float*)nullptr)
    }
    bf16_t* Wgu = Wb + (odd ? WO_GU : WE_GU); bf16_t* Wdn = Wb + (odd ? WO_DN : WE_DN); bf16_t* Wpg = Wb + (odd ? WO_PG : WE_PG); bf16_t* Wpu = Wb + (odd ? WO_PU : WE_PU);
    JOB(PIN(34) + (size_t)L * 1024 * 2816, 1024, 2816, Wgu, 1024, 0, 1, 0, PIN(3) + L * 1024)
    JOB(PIN(35) + (size_t)L * 1024 * 2816, 1024, 2816, Wgu, 1024, 0, 2, 0, PIN(3) + L * 1024)
    JOB(PIN(36) + (size_t)L * 2816 * 1024, 2816, 1024, Wdn, 2816, 0, 0, 0, (const float*)nullptr)
    JOB(PIN(38) + (size_t)L * 1024 * 1024, 1024, 1024, Wpg, 1024, 0, 0, 0, PIN(4) + L * 1024)
    JOB(PIN(37) + (size_t)L * 256 * 1024, 256, 1024, Wpu, 256, 0, 0, 0, (const float*)nullptr)
#undef JOB
    const u32x4 zero4 = zero_u4();
    if (!odd) {
        u32x4* zp = (u32x4*)(Wb + WE_IN + (size_t)3080 * 1024);
        for (int i = gtid; i < 248 * 128; i += NTH) zp[i] = zero4;
    } else {
        u32x4* zp = (u32x4*)(Wb + WO_LORA);
        for (int ch = gtid; ch < 1536 * 32; ch += NTH) { const int n = ch >> 5, c = ch & 31, kind = n >> 9;
            const bool live = kind == 0 ? (c < 8) : (kind == 1 ? (c >= 8 && c < 16) : (c >= 16));
            if (!live) zp[ch] = zero4; }
    }
}

__device__ __forceinline__ void ph_convert_p(const Params& P, int L, int tid) {
    const int gtid = blockIdx.x * 512 + tid, NTH = gridDim.x * 512;
    const float* p = PIN(1) + (size_t)L * T * 256; u32x4* pb = (u32x4*)(PWS() + OFF_PB);
    for (int i0 = gtid; i0 < T * 32; i0 += 8 * NTH) {
        f32x4 a[8], b[8];
#pragma unroll
        for (int e = 0; e < 8; ++e) { const int i = i0 + e * NTH; if (i < T * 32) { a[e] = *(const f32x4*)(p + (size_t)i * 8); b[e] = *(const f32x4*)(p + (size_t)i * 8 + 4); } else { a[e] = (f32x4){0.f, 0.f, 0.f, 0.f}; b[e] = a[e]; } }
#pragma unroll
        for (int e = 0; e < 8; ++e) { const int i = i0 + e * NTH; if (i < T * 32) { u32x4 w; w.x = cvt_pk_bf16(a[e][0], a[e][1]); w.y = cvt_pk_bf16(a[e][2], a[e][3]); w.z = cvt_pk_bf16(b[e][0], b[e][1]); w.w = cvt_pk_bf16(b[e][2], b[e][3]); pb[i] = w; } }
    }
}

__device__ __forceinline__ void ph_prologue(const Params& P, int tid) {
    const int lane = tid & 63, gw = blockIdx.x * 8 + (tid >> 6), NGW = gridDim.x * 8;
    const float* x = PIN(0); bf16_t* hb = (bf16_t*)(PWS() + OFF_HB); float* ssA = (float*)(PWS() + OFF_SS);
    for (int row0 = gw; row0 < T; row0 += 2 * NGW) {
        f32x4 v[2][4];
#pragma unroll
        for (int e = 0; e < 2; ++e) { const int row = row0 + e * NGW;
#pragma unroll
            for (int q = 0; q < 4; ++q) v[e][q] = (row < T) ? *((const f32x4*)(x + (size_t)row * 1024) + lane + 64 * q) : (f32x4){0.f, 0.f, 0.f, 0.f}; }
#pragma unroll
        for (int e = 0; e < 2; ++e) { const int row = row0 + e * NGW; if (row < T) { u32x2* br = (u32x2*)(hb + (size_t)row * 1024) + lane; float s = 0.f;
#pragma unroll
            for (int q = 0; q < 4; ++q) { const f32x4 w4 = v[e][q]; s += (w4[0] * w4[0] + w4[1] * w4[1]) + (w4[2] * w4[2] + w4[3] * w4[3]); u32x2 w; w.x = cvt_pk_bf16(w4[0], w4[1]); w.y = cvt_pk_bf16(w4[2], w4[3]); br[64 * q] = w; }
            s = wave_sum(s); if (lane < 16) ssA[(size_t)row * 16 + lane] = (lane == 0) ? s : 0.f; } }
    }
}
__device__ __forceinline__ void zero_f32(float* p, int n, int tid) { for (int i = blockIdx.x * 512 + tid; i < n; i += gridDim.x * 512) p[i] = 0.f; }
__device__ __forceinline__ void ph_final(const Params& P, int tid) {
    const int lane = tid & 63, gw = blockIdx.x * 8 + (tid >> 6), NGW = gridDim.x * 8;
    float* out = POUT(); const bf16_t* h = (const bf16_t*)(PWS() + OFF_HB); const float* ssA = (const float*)(PWS() + OFF_SS); const float* nw = PIN(5);
    f32x4 w0[2], w1[2];
#pragma unroll
    for (int q = 0; q < 2; ++q) { const int c = q * 512 + lane * 8; w0[q] = *(const f32x4*)(nw + c); w1[q] = *(const f32x4*)(nw + c + 4); }
    for (int row0 = gw; row0 < T; row0 += 2 * NGW) {
        u32x4 hv[2][2]; float rsv[2];
#pragma unroll
        for (int e = 0; e < 2; ++e) { const int row = row0 + e * NGW; const bool ok = row < T; rsv[e] = ok ? rsqrtf(rowss(ssA, row) * (1.0f / 1024.0f) + 1e-6f) : 0.f;
#pragma unroll
            for (int q = 0; q < 2; ++q) hv[e][q] = ok ? *(const u32x4*)(h + (size_t)row * 1024 + q * 512 + lane * 8) : (u32x4){0u, 0u, 0u, 0u}; }
#pragma unroll
        for (int e = 0; e < 2; ++e) { const int row = row0 + e * NGW; if (row < T) { const float rs = rsv[e];
#pragma unroll
            for (int q = 0; q < 2; ++q) { const int c = q * 512 + lane * 8; float hf[8]; unpack8(hv[e][q], hf);
                *(f32x4*)(out + (size_t)row * 1024 + c) = (f32x4){hf[0] * rs * w0[q][0], hf[1] * rs * w0[q][1], hf[2] * rs * w0[q][2], hf[3] * rs * w0[q][3]};
                *(f32x4*)(out + (size_t)row * 1024 + c + 4) = (f32x4){hf[4] * rs * w1[q][0], hf[5] * rs * w1[q][1], hf[6] * rs * w1[q][2], hf[7] * rs * w1[q][3]}; } } }
    }
}

__device__ __forceinline__ void ph_rg_prep(const Params& P, int j, LAS unsigned char* lds, int tid) {
    const int lane = tid & 63, g = tid >> 6, quad = lane >> 4, fr = lane & 15;
    const bf16_t* Z = (const bf16_t*)(PWS() + OFF_Z); bf16_t* HB = (bf16_t*)((unsigned char*)tabptr(41));
    LAS bf16_t* xb = (LAS bf16_t*)lds;
    const float* wr_ = PIN(9) + (size_t)(j * 8 + g) * 4096; const float* wi_ = PIN(11) + (size_t)(j * 8 + g) * 4096;
    bf16x8 Br[4][2], Bi[4][2];
#pragma unroll
    for (int nt = 0; nt < 4; ++nt)
#pragma unroll
        for (int ks = 0; ks < 2; ++ks) {
            float a[8], b[8];
#pragma unroll
            for (int q = 0; q < 8; ++q) { const int i = ks * 32 + quad * 8 + q, jj = nt * 16 + fr; a[q] = wr_[i * 64 + jj]; b[q] = wi_[i * 64 + jj]; }
            const u32x4 pa = pack8(a), pb = pack8(b); Br[nt][ks] = __builtin_bit_cast(bf16x8, pa); Bi[nt][ks] = __builtin_bit_cast(bf16x8, pb);
        }
    const int c0 = (tid & 63) * 8;
    float cw[4][8], cb[8];
#pragma unroll
    for (int k = 0; k < 4; ++k)
#pragma unroll
        for (int q = 0; q < 8; ++q) cw[k][q] = PIN(7)[(size_t)(j * 4 + k) * 512 + c0 + q];
#pragma unroll
    for (int q = 0; q < 8; ++q) cb[q] = PIN(8)[j * 512 + c0 + q];
    float ebr[4], ebi[4], espl[4];
#pragma unroll
    for (int nt = 0; nt < 4; ++nt) { const int col = g * 64 + nt * 16 + fr; ebr[nt] = PIN(10)[j * 512 + col]; ebi[nt] = PIN(12)[j * 512 + col]; espl[nt] = softplusf_(-PIN(13)[j * 512 + col]); }

    const int tg = tid >> 6;
    const u32x4 z4 = zero_u4();
    u32x4 rw[11];
#define RG_ROWS(tile_) { const int r0_ = (tile_) * 64 + tg * 8 - 3; _Pragma("unroll") for (int i = 0; i < 11; ++i) rw[i] = (r0_ + i >= 0) ? *(const u32x4*)(Z + (size_t)(r0_ + i) * EVN + c0) : z4; }
    if ((int)blockIdx.x < T / 64) RG_ROWS((int)blockIdx.x)
    for (int tile = blockIdx.x; tile < T / 64; tile += gridDim.x) {
        const int t0 = tile * 64, s0 = t0 & (SEQ - 1);
#pragma unroll
        for (int it = 0; it < 8; ++it) {
            const int tok = tg * 8 + it;
            float a8[8];
#pragma unroll
            for (int q = 0; q < 8; ++q) a8[q] = cb[q];
#pragma unroll
            for (int k = 0; k < 4; ++k) {
                if (s0 + tok - 3 + k >= 0) { float xf[8]; unpack8(rw[it + k], xf);
#pragma unroll
                    for (int q = 0; q < 8; ++q) a8[q] += cw[k][q] * xf[q]; } }
            *(LAS u32x4*)(xb + tok * 520 + c0) = pack8(a8);
        }
        if (tile + (int)gridDim.x < T / 64) RG_ROWS(tile + (int)gridDim.x)
        __syncthreads();
#pragma unroll 1
        for (int mt = 0; mt < 4; ++mt) {
            f32x4 dr[4], di[4];
#pragma unroll
            for (int nt = 0; nt < 4; ++nt) { dr[nt] = (f32x4){0.f, 0.f, 0.f, 0.f}; di[nt] = (f32x4){0.f, 0.f, 0.f, 0.f}; }
#pragma unroll
            for (int ks = 0; ks < 2; ++ks) {
                const bf16x8 a = *(const LAS bf16x8*)(xb + (mt * 16 + fr) * 520 + g * 64 + ks * 32 + quad * 8);
#pragma unroll
                for (int nt = 0; nt < 4; ++nt) { dr[nt] = __builtin_amdgcn_mfma_f32_16x16x32_bf16(a, Br[nt][ks], dr[nt], 0, 0, 0); di[nt] = __builtin_amdgcn_mfma_f32_16x16x32_bf16(a, Bi[nt][ks], di[nt], 0, 0, 0); }
            }
#pragma unroll
            for (int nt = 0; nt < 4; ++nt) {
                const int col = g * 64 + nt * 16 + fr;
#pragma unroll
                for (int q = 0; q < 4; ++q) {
                    const int tok = mt * 16 + quad * 4 + q; const float xv = bf2f(xb[tok * 520 + col]);
                    const float r = sigmoidf_(dr[nt][q] + ebr[nt]), ig = sigmoidf_(di[nt][q] + ebi[nt]);
                    const float la = -8.0f * r * espl[nt];
                    const float mult = (s0 + tok == 0) ? 1.0f : __builtin_amdgcn_sqrtf(fmaxf(1.0f - __expf(2.0f * la), 0.f));
                    const float uu = mult * ig * xv;
                    HB[(size_t)(t0 + tok) * 1024 + col] = f2bf(la); HB[(size_t)(t0 + tok) * 1024 + 512 + col] = f2bf(uu);
                }
            }
        }
        __syncthreads();
    }
}

#undef RG_ROWS
__device__ __forceinline__ void ph_rg_scan(const Params& P, int task, LAS unsigned char* lds, int tid) {
    const int b = task >> 5, cl = tid & 15, c = (task & 31) * 16 + cl, seg = tid >> 4;
    const bf16_t* Z = (const bf16_t*)(PWS() + OFF_Z); const bf16_t* HB = (const bf16_t*)((unsigned char*)tabptr(41)); bf16_t* MIX = (bf16_t*)((unsigned char*)tabptr(42));
    LAS float* sSL = (LAS float*)lds; LAS float* sH = sSL + 512;
    const size_t tb = (size_t)b * SEQ + (size_t)seg * 128;
    float H = 0.f, SL = 0.f;
    {
        bf16_t la16[16], u16[16], nla[16], nu[16];
#pragma unroll
        for (int k = 0; k < 16; ++k) { la16[k] = HB[(tb + k) * 1024 + c]; u16[k] = HB[(tb + k) * 1024 + 512 + c]; }
#pragma unroll 1
        for (int i0 = 0; i0 < 128; i0 += 16) {
            if (i0 + 16 < 128) {
#pragma unroll
                for (int k = 0; k < 16; ++k) { nla[k] = HB[(tb + i0 + 16 + k) * 1024 + c]; nu[k] = HB[(tb + i0 + 16 + k) * 1024 + 512 + c]; } }
#pragma unroll
            for (int k = 0; k < 16; ++k) { const float la = bf2f(la16[k]); H = __expf(la) * H + bf2f(u16[k]); SL += la; }
#pragma unroll
            for (int k = 0; k < 16; ++k) { la16[k] = nla[k]; u16[k] = nu[k]; }
        }
    }
    sSL[tid] = SL; sH[tid] = H;
    __syncthreads();
    float hc = 0.f;
    for (int s2 = 0; s2 < seg; ++s2) hc = __expf(sSL[s2 * 16 + cl]) * hc + sH[s2 * 16 + cl];
    H = hc;
    {
        bf16_t la16[16], u16[16], ya16[16], nla[16], nu[16], nya[16], o16[16];
#pragma unroll
        for (int k = 0; k < 16; ++k) { la16[k] = HB[(tb + k) * 1024 + c]; u16[k] = HB[(tb + k) * 1024 + 512 + c]; ya16[k] = Z[(tb + k) * EVN + 512 + c]; }
#pragma unroll 1
        for (int i0 = 0; i0 < 128; i0 += 16) {
            if (i0 + 16 < 128) {
#pragma unroll
                for (int k = 0; k < 16; ++k) { nla[k] = HB[(tb + i0 + 16 + k) * 1024 + c]; nu[k] = HB[(tb + i0 + 16 + k) * 1024 + 512 + c]; nya[k] = Z[(tb + i0 + 16 + k) * EVN + 512 + c]; } }
#pragma unroll
            for (int k = 0; k < 16; ++k) { H = __expf(bf2f(la16[k])) * H + bf2f(u16[k]); o16[k] = f2bf(H * gelu_tanh(bf2f(ya16[k]))); }
#pragma unroll
            for (int k = 0; k < 16; ++k) MIX[(tb + i0 + k) * 1024 + c] = o16[k];
#pragma unroll
            for (int k = 0; k < 16; ++k) { la16[k] = nla[k]; u16[k] = nu[k]; ya16[k] = nya[k]; }
        }
    }
    __syncthreads();
}

__device__ __forceinline__ void ph_gdn_prep(const Params& P, int j, int tid) {
    const int lane = tid & 63, gw = blockIdx.x * 8 + (tid >> 6), NGW = gridDim.x * 8;
    const int role = gw % 3, wi = gw / 3, nW = (NGW - role + 2) / 3;
    const bf16_t* Z = (const bf16_t*)(PWS() + OFF_Z); bf16_t* QK = (bf16_t*)(PWS() + OFF_QK); bf16_t* VP = (bf16_t*)(PWS() + OFF_EXT); float* GT = (float*)(PWS() + OFF_LA);
    const int head = lane >> 4, il = lane & 15, ch = head * 128 + il * 8;
    float cw[4][8];
#pragma unroll
    for (int k = 0; k < 4; ++k)
#pragma unroll
        for (int q = 0; q < 8; ++q) cw[k][q] = PIN(14)[(size_t)(j * 4 + k) * 1536 + role * 512 + ch + q];
    const float nalog = (lane < 4) ? -__expf(PIN(15)[j * 4 + (lane & 3)]) : 0.f, dtb = (lane < 4) ? PIN(16)[j * 4 + (lane & 3)] : 0.f;
    const int per = (T + nW - 1) / nW, tb = wi * per, te = (tb + per < T) ? (tb + per) : T;
    if (tb < te) {
        const u32x4 z4 = zero_u4();
        const bf16_t* zc = Z + 1024 + role * 512 + ch;
        u32x4 rows[7], nx[4];
#pragma unroll
        for (int i = 0; i < 7; ++i) { const int r = tb - 3 + i; rows[i] = (r >= 0 && r < T) ? *(const u32x4*)(zc + (size_t)r * EVN) : z4; }
        bf16_t ga[4] = {0, 0, 0, 0}, gb[4] = {0, 0, 0, 0};
        if (role == 2 && lane < 4) {
#pragma unroll
            for (int e = 0; e < 4; ++e) { const int tt = tb + e; if (tt < te) { ga[e] = Z[(size_t)tt * EVN + 3072 + lane]; gb[e] = Z[(size_t)tt * EVN + 3076 + lane]; } } }
#pragma unroll 1
        for (int t = tb; t < te; t += 4) {
#pragma unroll
            for (int i = 0; i < 4; ++i) { const int r = t + 4 + i; nx[i] = (t + 4 < te && r < T) ? *(const u32x4*)(zc + (size_t)r * EVN) : z4; }
            bf16_t na[4] = {0, 0, 0, 0}, nb[4] = {0, 0, 0, 0};
            if (role == 2 && lane < 4) {
#pragma unroll
                for (int e = 0; e < 4; ++e) { const int tt = t + 4 + e; if (tt < te) { na[e] = Z[(size_t)tt * EVN + 3072 + lane]; nb[e] = Z[(size_t)tt * EVN + 3076 + lane]; } } }
#pragma unroll
            for (int e = 0; e < 4; ++e) { const int tt = t + e; if (tt < te) {
                const int s0 = tt & (SEQ - 1);
                float a8[8];
#pragma unroll
                for (int q = 0; q < 8; ++q) a8[q] = 0.f;
#pragma unroll
                for (int k = 0; k < 4; ++k) { float xf[8]; unpack8((s0 - 3 + k >= 0) ? rows[e + k] : z4, xf);
#pragma unroll
                    for (int q = 0; q < 8; ++q) a8[q] += cw[k][q] * xf[q]; }
                float ss = 0.f;
#pragma unroll
                for (int q = 0; q < 8; ++q) { a8[q] = siluf_(a8[q]); ss += a8[q] * a8[q]; }
                if (role < 2) { ss = rowsum16(ss); const float sc = rsqrtf(ss + 1e-6f) * (role == 0 ? 0.08838834764831845f : 1.0f);
#pragma unroll
                    for (int q = 0; q < 8; ++q) a8[q] *= sc;
                    *(u32x4*)(QK + (size_t)tt * 1024 + head * 256 + role * 128 + il * 8) = pack8(a8); }
                else { *(u32x4*)(VP + (size_t)tt * 512 + ch) = pack8(a8);
                    if (lane < 4) { GT[(size_t)tt * 8 + lane] = __expf(nalog * softplusf_(bf2f(ga[e]) + dtb)); GT[(size_t)tt * 8 + 4 + lane] = sigmoidf_(bf2f(gb[e])); } } } }
#pragma unroll
            for (int e = 0; e < 4; ++e) { ga[e] = na[e]; gb[e] = nb[e]; }
            rows[0] = rows[4]; rows[1] = rows[5]; rows[2] = rows[6];
#pragma unroll
            for (int i = 0; i < 4; ++i) rows[3 + i] = nx[i];
        }
    }
}

__device__ __forceinline__ void ph_gdn(const Params& P, int j, int task, LAS unsigned char* lds, int tid) {
    const int lane = tid & 63, wid = tid >> 6;
    const int bh = task >> 3, b = bh >> 2, hh = bh & 3, cgp = task & 7;
    const bf16_t* QK = (const bf16_t*)(PWS() + OFF_QK); const bf16_t* VP = (const bf16_t*)(PWS() + OFF_EXT); const float* GT = (const float*)(PWS() + OFF_LA); bf16_t* MIX = (bf16_t*)((unsigned char*)tabptr(42));
    constexpr int NC = SEQ / 32, STB = 35328;
    LAS unsigned char* stg = lds;
    LAS bf16_t* soutb = (LAS bf16_t*)(lds + 2 * STB);
    const bool stager = wid >= 4; const int stid = tid - 256;
    f32x4 S4[2];
#pragma unroll
    for (int q = 0; q < 2; ++q) S4[q] = (f32x4){0.f, 0.f, 0.f, 0.f};
    u32x4 R[5]; float ga = 0.f, gb = 0.f;
    const u32x4 zero4 = zero_u4();
#define GDN_LOAD(cc) { const size_t t0_ = (size_t)b * SEQ + (size_t)(cc) * 32; _Pragma("unroll") for (int i = 0; i < 5; ++i) { const int p = stid + 256 * i; \
        if (p < 1024) R[i] = *(const u32x4*)(QK + (t0_ + (p >> 5)) * 1024 + hh * 256 + (p & 31) * 8); \
        else if (p < 1088) R[i] = *(const u32x4*)(VP + (t0_ + ((p - 1024) >> 1)) * 512 + hh * 128 + cgp * 16 + ((p - 1024) & 1) * 8); \
        else R[i] = zero4; } \
        if (stid < 32) { ga = GT[(t0_ + stid) * 8 + hh]; gb = GT[(t0_ + stid) * 8 + 4 + hh]; } }
#define GDN_TRANSFORM(buf) { LAS float* sq_ = (LAS float*)(stg + (buf) * STB); LAS float* sk_ = sq_ + 32 * 128; LAS float* sv_ = sk_ + 32 * 128; LAS float* seg_ = sv_ + 32 * 16; LAS float* sbt_ = seg_ + 32; \
        _Pragma("unroll") for (int i = 0; i < 5; ++i) { const int p = stid + 256 * i; float xf[8]; unpack8(R[i], xf); LAS float* dst = nullptr; \
            if (p < 1024) { const int rr = p >> 5, pc = p & 31; dst = (pc < 16) ? (sq_ + rr * 128 + pc * 8) : (sk_ + rr * 128 + (pc - 16) * 8); } \
            else if (p < 1088) { dst = sv_ + ((p - 1024) >> 1) * 16 + ((p - 1024) & 1) * 8; } \
            if (p < 1088) { *(LAS f32x4*)dst = (f32x4){xf[0], xf[1], xf[2], xf[3]}; *(LAS f32x4*)(dst + 4) = (f32x4){xf[4], xf[5], xf[6], xf[7]}; } } \
        if (stid < 32) { seg_[stid] = ga; sbt_[stid] = gb; } }
#define GDN_FLUSH(cc) { if (stid < 64) { const int s_ = stid >> 1, pc = stid & 1; \
        *(u32x4*)(MIX + (size_t)(b * SEQ + (cc) * 32 + s_) * 1024 + 512 + hh * 128 + cgp * 16 + pc * 8) = *(const LAS u32x4*)(soutb + ((cc) & 1) * 512 + s_ * 16 + pc * 8); } }
#define GDN_REC(buf, s_lo, cc) { const LAS float* sq_ = (const LAS float*)(stg + (buf) * STB); const LAS float* sk_ = sq_ + 32 * 128; const LAS float* sv_ = sk_ + 32 * 128; const LAS float* seg_ = sv_ + 32 * 16; const LAS float* sbt_ = seg_ + 32; \
        LAS bf16_t* so_ = soutb + ((cc) & 1) * 512; \
        f32x4 ck[2], cq[2], pq[2]; \
        _Pragma("unroll") for (int i = 0; i < 2; ++i) { ck[i] = *(const LAS f32x4*)(sk_ + (s_lo) * 128 + 64 * i + rq); cq[i] = *(const LAS f32x4*)(sq_ + (s_lo) * 128 + 64 * i + rq); pq[i] = cq[i]; } \
        float cv = sv_[(s_lo) * 16 + col], ceg = seg_[(s_lo)], cbt = sbt_[(s_lo)]; float oacc = 0.f; \
        _Pragma("unroll") for (int u = 0; u < 16; ++u) { const int sn = (s_lo) + u + 1; \
            f32x4 nk[2], nq[2]; \
            _Pragma("unroll") for (int i = 0; i < 2; ++i) { nk[i] = *(const LAS f32x4*)(sk_ + sn * 128 + 64 * i + rq); nq[i] = *(const LAS f32x4*)(sq_ + sn * 128 + 64 * i + rq); } \
            const float nv = sv_[sn * 16 + col], neg = seg_[sn], nbt = sbt_[sn]; \
              \
            f32x2 a2 = ck[0].xy * S4[0].xy, b2 = pq[0].xy * S4[0].xy; a2 += ck[0].zw * S4[0].zw; b2 += pq[0].zw * S4[0].zw; a2 += ck[1].xy * S4[1].xy; b2 += pq[1].xy * S4[1].xy; a2 += ck[1].zw * S4[1].zw; b2 += pq[1].zw * S4[1].zw;     \
            float pk = a2[0] + a2[1], pp = b2[0] + b2[1]; \
            pk += dppf<0xB1>(pk); pp += dppf<0xB1>(pp); pk += dppf<0x4E>(pk); pp += dppf<0x4E>(pp); pk += dppf<0x141>(pk); pp += dppf<0x141>(pp); pk += dppf<0x140>(pk); pp += dppf<0x140>(pp); \
            if (u > 0) oacc = (il == u - 1) ? pp : oacc; \
            const float dl = cbt * (cv - ceg * pk); \
            _Pragma("unroll") for (int i = 0; i < 2; ++i) S4[i] = S4[i] * ceg + ck[i] * dl; \
            _Pragma("unroll") for (int i = 0; i < 2; ++i) { pq[i] = cq[i]; ck[i] = nk[i]; cq[i] = nq[i]; } \
            cv = nv; ceg = neg; cbt = nbt; \
            __builtin_amdgcn_sched_barrier(0); } \
        { f32x2 b2 = pq[0].xy * S4[0].xy; b2 += pq[0].zw * S4[0].zw; b2 += pq[1].xy * S4[1].xy; b2 += pq[1].zw * S4[1].zw; float pp = b2[0] + b2[1]; pp = rowsum16(pp); \
          oacc = (il == 15) ? pp : oacc; so_[((s_lo) + il) * 16 + col] = f2bf(oacc); } }
    const int il = lane & 15, col = (wid & 3) * 4 + (lane >> 4), rq = il * 4;
    if (stager) { GDN_LOAD(0) GDN_TRANSFORM(0) GDN_LOAD(1) } else __builtin_amdgcn_s_setprio(2);
    __syncthreads();
#pragma unroll 1
    for (int c = 0; c < NC; ++c) {
        if (stager) { if (c > 0) GDN_FLUSH(c - 1) }
        else GDN_REC(c & 1, 0, c)
        __syncthreads();
        if (stager) { if (c + 1 < NC) GDN_TRANSFORM((c + 1) & 1) if (c + 2 < NC) GDN_LOAD(c + 2) }
        else GDN_REC(c & 1, 16, c)
        __syncthreads();
    }
    if (stager) GDN_FLUSH(NC - 1) else __builtin_amdgcn_s_setprio(0);
#undef GDN_LOAD
#undef GDN_TRANSFORM
#undef GDN_FLUSH
#undef GDN_REC
    __syncthreads();
}

__device__ __forceinline__ void ph_gdn_post(const Params& P, int j, int tid) {
    const int lane = tid & 63, gw = blockIdx.x * 8 + (tid >> 6), NGW = gridDim.x * 8;
    const bf16_t* Z = (const bf16_t*)(PWS() + OFF_Z); bf16_t* MIX = (bf16_t*)((unsigned char*)tabptr(42));
    const int head = lane >> 4, il = lane & 15;
    float nw[8];
#pragma unroll
    for (int q = 0; q < 8; ++q) nw[q] = PIN(17)[j * 128 + il * 8 + q];
    u32x4 wo[2], wz[2], nwo[2], nwz[2];
    const u32x4 z4 = zero_u4();
#define GP_LOAD(WO, WZ, t0_) { _Pragma("unroll") for (int e = 0; e < 2; ++e) { const int t = (t0_) + e * NGW; \
        if (t < T) { WO[e] = *(const u32x4*)(MIX + (size_t)t * 1024 + 512 + head * 128 + il * 8); WZ[e] = *(const u32x4*)(Z + (size_t)t * EVN + 2560 + head * 128 + il * 8); } else { WO[e] = z4; WZ[e] = z4; } } }
    GP_LOAD(wo, wz, gw)
    for (int t0 = gw; t0 < T; t0 += 2 * NGW) {
        GP_LOAD(nwo, nwz, t0 + 2 * NGW)
#pragma unroll
        for (int e = 0; e < 2; ++e) { const int t = t0 + e * NGW; if (t < T) {
            float o[8], zg[8]; unpack8(wo[e], o); unpack8(wz[e], zg);
            float ss = 0.f;
#pragma unroll
            for (int q = 0; q < 8; ++q) ss += o[q] * o[q];
            ss = rowsum16(ss); const float rs = rsqrtf(ss * (1.0f / 128.0f) + 1e-6f);
#pragma unroll
            for (int q = 0; q < 8; ++q) o[q] = o[q] * rs * nw[q] * siluf_(zg[q]);
            *(u32x4*)(MIX + (size_t)t * 1024 + 512 + head * 128 + il * 8) = pack8(o); } }
#pragma unroll
        for (int e = 0; e < 2; ++e) { wo[e] = nwo[e]; wz[e] = nwz[e]; }
    }
#undef GP_LOAD
}

__device__ __forceinline__ void ph_lora_prep(const Params& P, int j, int tid) {
    const bf16_t* Z = (const bf16_t*)(PWS() + OFF_Z); bf16_t* LA = (bf16_t*)(PWS() + OFF_LA);
    const int grp = tid & 31;
    float mu[8];
#pragma unroll
    for (int q = 0; q < 8; ++q) mu[q] = PIN(22)[(size_t)j * 1792 + 1536 + grp * 8 + q];
    const int NTH = gridDim.x * 512;
    for (int item0 = blockIdx.x * 512 + tid; item0 < T * 32; item0 += 8 * NTH) {
        u32x4 wc[8], wp[8];
#pragma unroll
        for (int e = 0; e < 8; ++e) { const int item = item0 + e * NTH; const int t = item >> 5; const size_t zo = (size_t)t * ODN + 2048 + 1536 + grp * 8;
            wc[e] = (item < T * 32) ? *(const u32x4*)(Z + zo) : (u32x4){0u, 0u, 0u, 0u};
            wp[e] = (item < T * 32 && (t & (SEQ - 1)) != 0) ? *(const u32x4*)(Z + zo - ODN) : (u32x4){0u, 0u, 0u, 0u}; }
#pragma unroll
        for (int e = 0; e < 8; ++e) { const int item = item0 + e * NTH; if (item < T * 32) { const int t = item >> 5;
            float cur[8], prv[8], o[8]; unpack8(wc[e], cur); unpack8(wp[e], prv);
#pragma unroll
            for (int q = 0; q < 8; ++q) { const float m = cur[q] + mu[q] * (prv[q] - cur[q]); o[q] = grp < 8 ? (1.0f - 2.0f * __builtin_amdgcn_rcpf(1.0f + __expf(2.0f * m))) : (grp < 16 ? m : sigmoidf_(m));     }
            *(u32x4*)(LA + (size_t)t * 256 + grp * 8) = pack8(o); } }
    }
}

__device__ __forceinline__ void ph_hgrn(const Params& P, int j, int task, LAS unsigned char* lds, int tid) {
    const int lane = tid & 63, wid = tid >> 6;
    const int bh = task >> 2, b = bh >> 2, hh = bh & 3, cgp = task & 3;
    const bf16_t* Z = (const bf16_t*)(PWS() + OFF_Z); bf16_t* MIX = (bf16_t*)((unsigned char*)tabptr(42));
    constexpr int NC = SEQ / 32, STB = 37120;
    LAS unsigned char* stg = lds; LAS bf16_t* soutb = (LAS bf16_t*)(lds + 2 * STB); LAS float* slb = (LAS float*)(lds + 2 * STB + 4096);
    if (tid < 128) { float lb = 0.f; if (j > 0) { const float x0 = PIN(20)[hh * 128 + tid], x1 = PIN(20)[512 + hh * 128 + tid]; lb = fmaxf(sigmoidf_(x1 - x0), 0.f); } slb[tid] = lb; }
    __syncthreads();
    const bool stager = wid >= 4; const int stid = tid - 256;
    f32x4 S4[4];
#pragma unroll
    for (int q = 0; q < 4; ++q) S4[q] = (f32x4){0.f, 0.f, 0.f, 0.f};
    u32x4 R[5];
    const u32x4 zero4 = zero_u4();
#define HG_LOAD(cc) { const size_t t0_ = (size_t)b * SEQ + (size_t)(cc) * 32; _Pragma("unroll") for (int i = 0; i < 5; ++i) { const int p = stid + 256 * i; const int rr = p / 36, pc = p - rr * 36; \
        const int col = pc < 16 ? (hh * 128 + pc * 8) : (pc < 32 ? (512 + hh * 128 + (pc - 16) * 8) : (1024 + hh * 128 + cgp * 32 + (pc - 32) * 8)); \
        R[i] = (p < 1152) ? *(const u32x4*)(Z + (t0_ + rr) * ODN + col) : zero4; } }
#define HG_TRANSFORM(buf) { LAS float* sq_ = (LAS float*)(stg + (buf) * STB); LAS float* sf_ = sq_ + 32 * 128; LAS float* sv_ = sf_ + 32 * 128; \
        _Pragma("unroll") for (int i = 0; i < 5; ++i) { const int p = stid + 256 * i; if (p < 1152) { const int rr = p / 36, pc = p - rr * 36; float xf[8]; unpack8(R[i], xf); LAS float* dst; \
            if (pc < 16) { _Pragma("unroll") for (int q = 0; q < 8; ++q) xf[q] = siluf_(xf[q]); dst = sq_ + rr * 128 + pc * 8; } \
            else if (pc < 32) { const int d0 = (pc - 16) * 8; _Pragma("unroll") for (int q = 0; q < 8; ++q) { const float lb = slb[d0 + q]; xf[q] = lb + (1.0f - lb) * sigmoidf_(xf[q]); } dst = sf_ + rr * 128 + d0; } \
            else dst = sv_ + rr * 32 + (pc - 32) * 8; \
            *(LAS f32x4*)dst = (f32x4){xf[0], xf[1], xf[2], xf[3]}; *(LAS f32x4*)(dst + 4) = (f32x4){xf[4], xf[5], xf[6], xf[7]}; } } }
#define HG_FLUSH(cc) { if (stid < 128) { const int s_ = stid >> 2, pc = stid & 3; \
        *(u32x4*)(MIX + ((size_t)b * SEQ + (size_t)(cc) * 32 + s_) * 1024 + hh * 128 + cgp * 32 + pc * 8) = *(const LAS u32x4*)(soutb + ((cc) & 1) * 1024 + s_ * 32 + pc * 8); } }
#define HG_REC(buf, s_lo, cc) { const LAS float* sq_ = (const LAS float*)(stg + (buf) * STB); const LAS float* sf_ = sq_ + 32 * 128; const LAS float* sv_ = sf_ + 32 * 128; LAS bf16_t* so_ = soutb + ((cc) & 1) * 1024; \
        f32x4 cf[4], cq[4]; \
        _Pragma("unroll") for (int i = 0; i < 4; ++i) { cf[i] = *(const LAS f32x4*)(sf_ + (s_lo) * 128 + rq + 32 * i); cq[i] = *(const LAS f32x4*)(sq_ + (s_lo) * 128 + rq + 32 * i); } \
        float cv = sv_[(s_lo) * 32 + col]; \
        _Pragma("unroll 1") for (int g = 0; g < 2; ++g) { float oacc = 0.f; \
            _Pragma("unroll") for (int u = 0; u < 8; ++u) { const int sn = (s_lo) + g * 8 + u + 1; \
                f32x4 nf[4], nq[4]; \
                _Pragma("unroll") for (int i = 0; i < 4; ++i) { nf[i] = *(const LAS f32x4*)(sf_ + sn * 128 + rq + 32 * i); nq[i] = *(const LAS f32x4*)(sq_ + sn * 128 + rq + 32 * i); } \
                const float nv = sv_[sn * 32 + col]; \
                _Pragma("unroll") for (int i = 0; i < 4; ++i) S4[i] = cf[i] * (S4[i] - cv) + cv; \
                f32x2 b2 = cq[0].xy * S4[0].xy, c2 = cq[0].zw * S4[0].zw; b2 += cq[1].xy * S4[1].xy; c2 += cq[1].zw * S4[1].zw; b2 += cq[2].xy * S4[2].xy; c2 += cq[2].zw * S4[2].zw; b2 += cq[3].xy * S4[3].xy; c2 += cq[3].zw * S4[3].zw; b2 += c2; \
                float po = b2[0] + b2[1]; po = rowsum8(po); \
                oacc = (l8 == u) ? po : oacc; \
                _Pragma("unroll") for (int i = 0; i < 4; ++i) { cf[i] = nf[i]; cq[i] = nq[i]; } \
                cv = nv; \
                __builtin_amdgcn_sched_barrier(0); } \
            so_[((s_lo) + g * 8 + l8) * 32 + col] = f2bf(oacc); } }
    const int col = (wid & 3) * 8 + (lane >> 3), rq = (lane & 7) * 4, l8 = lane & 7;
    if (stager) { HG_LOAD(0) HG_TRANSFORM(0) HG_LOAD(1) } else __builtin_amdgcn_s_setprio(2);
    __syncthreads();
#pragma unroll 1
    for (int c = 0; c < NC; ++c) {
        if (stager) { if (c > 0) HG_FLUSH(c - 1) }
        else HG_REC(c & 1, 0, c)
        __syncthreads();
        if (stager) { if (c + 1 < NC) HG_TRANSFORM((c + 1) & 1) if (c + 2 < NC) HG_LOAD(c + 2) }
        else HG_REC(c & 1, 16, c)
        __syncthreads();
    }
    if (stager) HG_FLUSH(NC - 1) else __builtin_amdgcn_s_setprio(0);
#undef HG_LOAD
#undef HG_TRANSFORM
#undef HG_FLUSH
#undef HG_REC
    __syncthreads();
}

__device__ __forceinline__ void ph_rwkv(const Params& P, int j, int task, LAS unsigned char* lds, int tid) {
    const int lane = tid & 63, wid = tid >> 6, il = lane & 15;
    const int bh = task >> 1, b = bh >> 3, hh = bh & 7, half = task & 1;
    const bf16_t* Z = (const bf16_t*)(PWS() + OFF_Z); const bf16_t* HB = (const bf16_t*)((unsigned char*)tabptr(41)); bf16_t* EXT = (bf16_t*)(PWS() + OFF_EXT);
    constexpr int NC = SEQ / 32, STB = 45312;
    LAS bf16_t* raw1 = (LAS bf16_t*)lds;
    LAS bf16_t* raw2 = (LAS bf16_t*)(lds + 10752);
    LAS unsigned char* stg = lds + 18944; LAS bf16_t* soutb = (LAS bf16_t*)(lds + 18944 + 2 * STB);
    const bool stager = wid >= 4; const int stid = tid - 256;
    const int j0 = il * 4, v4 = (stid & 7) * 4;
    float mur[4], muk[4], muv[4], kkw[4], kaw[4], w0v[4], a0v[4];
#pragma unroll
    for (int q = 0; q < 4; ++q) { mur[q] = PIN(22)[(size_t)j * 1792 + hh * 64 + j0 + q]; muk[q] = PIN(22)[(size_t)j * 1792 + 512 + hh * 64 + j0 + q];
        muv[q] = PIN(22)[(size_t)j * 1792 + 1024 + hh * 64 + half * 32 + v4 + q]; kkw[q] = PIN(28)[j * 512 + hh * 64 + j0 + q]; kaw[q] = PIN(29)[j * 512 + hh * 64 + j0 + q];
        w0v[q] = PIN(23)[j * 512 + hh * 64 + j0 + q]; a0v[q] = PIN(25)[j * 512 + hh * 64 + j0 + q]; }
    f32x4 S4[2] = {(f32x4){0.f, 0.f, 0.f, 0.f}, (f32x4){0.f, 0.f, 0.f, 0.f}};
    u32x4 R[5];
    const u32x4 zero4 = zero_u4();
#define R7_LOAD(cc) { const size_t t0_ = (size_t)b * SEQ + (size_t)(cc) * 32; _Pragma("unroll") for (int i = 0; i < 5; ++i) { const int p = stid + 256 * i; u32x4 val = zero4; \
        if (p < 660) { const int rr = p / 20, pc = p - rr * 20; if ((cc) * 32 - 1 + rr >= 0) { \
            const int col = pc < 8 ? (2048 + hh * 64 + pc * 8) : (pc < 16 ? (2560 + hh * 64 + (pc - 8) * 8) : (3072 + hh * 64 + half * 32 + (pc - 16) * 8)); \
            val = *(const u32x4*)(Z + (t0_ - 1 + rr) * ODN + col); } } \
        else if (p < 1172) { const int p2 = p - 660, rr = p2 >> 4, pc = p2 & 15; \
            val = *(const u32x4*)(HB + (t0_ + rr) * 1024 + (pc < 8 ? (hh * 64 + pc * 8) : (512 + hh * 64 + (pc - 8) * 8))); } \
        R[i] = val; } }
#define R7_STORE_RAW() { _Pragma("unroll") for (int i = 0; i < 5; ++i) { const int p = stid + 256 * i; \
        if (p < 660) { const int rr = p / 20, pc = p - rr * 20; *(LAS u32x4*)(raw1 + rr * 160 + pc * 8) = R[i]; } \
        else if (p < 1172) { const int p2 = p - 660, rr = p2 >> 4, pc = p2 & 15; *(LAS u32x4*)(raw2 + rr * 128 + pc * 8) = R[i]; } } }
#define R7_TRANSFORM(buf) { LAS float* sr_ = (LAS float*)(stg + (buf) * STB); LAS float* skp_ = sr_ + 2048; LAS float* snk_ = skp_ + 2048; LAS float* sbb_ = snk_ + 2048; LAS float* sw_ = sbb_ + 2048; LAS float* sv_ = sw_ + 2048; \
        _Pragma("unroll 1") for (int it = 0; it < 2; ++it) { const int tok = it * 16 + (stid >> 4); \
            float rc[4], rp[4], kc[4], kp_[4], lw[4], av[4]; \
            unpack4(*(const LAS u32x2*)(raw1 + (tok + 1) * 160 + j0), rc); unpack4(*(const LAS u32x2*)(raw1 + tok * 160 + j0), rp); \
            unpack4(*(const LAS u32x2*)(raw1 + (tok + 1) * 160 + 64 + j0), kc); unpack4(*(const LAS u32x2*)(raw1 + tok * 160 + 64 + j0), kp_); \
            unpack4(*(const LAS u32x2*)(raw2 + tok * 128 + j0), lw); unpack4(*(const LAS u32x2*)(raw2 + tok * 128 + 64 + j0), av); \
            float r[4], k[4], kk[4], ss = 0.f; \
            _Pragma("unroll") for (int q = 0; q < 4; ++q) { av[q] = sigmoidf_(av[q] + a0v[q]); lw[q] = -0.6065306597126334f * sigmoidf_(lw[q] + w0v[q]); r[q] = rc[q] + mur[q] * (rp[q] - rc[q]); k[q] = kc[q] + muk[q] * (kp_[q] - kc[q]); kk[q] = k[q] * kkw[q]; ss += kk[q] * kk[q]; } \
            ss = rowsum16(ss); const float sc = rsqrtf(ss + 1e-6f); \
            f32x4 o_r, o_kp, o_nk, o_bb, o_w; \
            _Pragma("unroll") for (int q = 0; q < 4; ++q) { const float kn = kk[q] * sc; o_r[q] = r[q]; o_kp[q] = k[q] * (1.0f + (av[q] - 1.0f) * kaw[q]); o_nk[q] = -kn; o_bb[q] = kn * av[q]; o_w[q] = __expf(lw[q]); } \
            *(LAS f32x4*)(sr_ + tok * 64 + j0) = o_r; *(LAS f32x4*)(skp_ + tok * 64 + j0) = o_kp; *(LAS f32x4*)(snk_ + tok * 64 + j0) = o_nk; *(LAS f32x4*)(sbb_ + tok * 64 + j0) = o_bb; *(LAS f32x4*)(sw_ + tok * 64 + j0) = o_w; } \
        { const int tok = stid >> 3; float vc[4], vp[4]; unpack4(*(const LAS u32x2*)(raw1 + (tok + 1) * 160 + 128 + v4), vc); unpack4(*(const LAS u32x2*)(raw1 + tok * 160 + 128 + v4), vp); \
          f32x4 o_v; \
          _Pragma("unroll") for (int q = 0; q < 4; ++q) o_v[q] = vc[q] + muv[q] * (vp[q] - vc[q]); \
          *(LAS f32x4*)(sv_ + tok * 32 + v4) = o_v; } }
#define R7_FLUSH(cc) { if (stid < 128) { const int s_ = stid >> 2, pc = stid & 3; \
        *(u32x4*)(EXT + ((size_t)b * SEQ + (size_t)(cc) * 32 + s_) * 512 + hh * 64 + half * 32 + pc * 8) = *(const LAS u32x4*)(soutb + ((cc) & 1) * 1024 + s_ * 32 + pc * 8); } }
#define R7_REC(buf, s_lo, cc) { const LAS float* sr_ = (const LAS float*)(stg + (buf) * STB); const LAS float* skp_ = sr_ + 2048; const LAS float* snk_ = skp_ + 2048; const LAS float* sbb_ = snk_ + 2048; const LAS float* sw_ = sbb_ + 2048; const LAS float* sv_ = sw_ + 2048; \
        LAS bf16_t* so_ = soutb + ((cc) & 1) * 1024; \
        f32x4 cr[2], ck[2], cn[2], cb[2], cw[2], pr[2]; \
        _Pragma("unroll") for (int i = 0; i < 2; ++i) { cr[i] = *(const LAS f32x4*)(sr_ + (s_lo) * 64 + c8 + 4 * i); ck[i] = *(const LAS f32x4*)(skp_ + (s_lo) * 64 + c8 + 4 * i); cn[i] = *(const LAS f32x4*)(snk_ + (s_lo) * 64 + c8 + 4 * i); \
            cb[i] = *(const LAS f32x4*)(sbb_ + (s_lo) * 64 + c8 + 4 * i); cw[i] = *(const LAS f32x4*)(sw_ + (s_lo) * 64 + c8 + 4 * i); pr[i] = cr[i]; } \
        float cv = sv_[(s_lo) * 32 + row], oacc = 0.f; \
        _Pragma("unroll 1") for (int g = 0; g < 2; ++g) { \
            _Pragma("unroll") for (int u = 0; u < 8; ++u) { const int sn = (s_lo) + g * 8 + u + 1; \
                f32x4 nr[2], nk[2], nn[2], nb[2], nw[2]; \
                _Pragma("unroll") for (int i = 0; i < 2; ++i) { nr[i] = *(const LAS f32x4*)(sr_ + sn * 64 + c8 + 4 * i); nk[i] = *(const LAS f32x4*)(skp_ + sn * 64 + c8 + 4 * i); nn[i] = *(const LAS f32x4*)(snk_ + sn * 64 + c8 + 4 * i); \
                    nb[i] = *(const LAS f32x4*)(sbb_ + sn * 64 + c8 + 4 * i); nw[i] = *(const LAS f32x4*)(sw_ + sn * 64 + c8 + 4 * i); } \
                const float nv = sv_[sn * 32 + row]; \
                  \
                f32x2 a2 = S4[0].xy * cn[0].xy, b2 = S4[0].xy * pr[0].xy; a2 += S4[0].zw * cn[0].zw; b2 += S4[0].zw * pr[0].zw; a2 += S4[1].xy * cn[1].xy; b2 += S4[1].xy * pr[1].xy; a2 += S4[1].zw * cn[1].zw; b2 += S4[1].zw * pr[1].zw;     \
                float sa = a2[0] + a2[1], yp = b2[0] + b2[1]; \
                sa += dppf<0xB1>(sa); yp += dppf<0xB1>(yp); sa += dppf<0x4E>(sa); yp += dppf<0x4E>(yp); sa += dppf<0x141>(sa); yp += dppf<0x141>(yp); \
                if (u == 0) { if (g > 0) { oacc = (l8 == 7) ? yp : oacc; so_[((s_lo) + (g - 1) * 8 + l8) * 32 + row] = f2bf(oacc); } } \
                else oacc = (l8 == u - 1) ? yp : oacc; \
                _Pragma("unroll") for (int i = 0; i < 2; ++i) S4[i] = S4[i] * cw[i] + cb[i] * sa + ck[i] * cv; \
                _Pragma("unroll") for (int i = 0; i < 2; ++i) { pr[i] = cr[i]; cr[i] = nr[i]; ck[i] = nk[i]; cn[i] = nn[i]; cb[i] = nb[i]; cw[i] = nw[i]; } \
                cv = nv; \
                __builtin_amdgcn_sched_barrier(0); } } \
        { f32x2 b2 = S4[0].xy * pr[0].xy; b2 += S4[0].zw * pr[0].zw; b2 += S4[1].xy * pr[1].xy; b2 += S4[1].zw * pr[1].zw; float yp = b2[0] + b2[1]; yp = rowsum8(yp); \
          oacc = (l8 == 7) ? yp : oacc; so_[((s_lo) + 8 + l8) * 32 + row] = f2bf(oacc); } }
    const int row = (wid & 3) * 8 + (lane >> 3), c8 = (lane & 7) * 8, l8 = lane & 7;
    if (stager) R7_LOAD(0) else __builtin_amdgcn_s_setprio(2);
    if (stager) R7_STORE_RAW()
    __syncthreads();
    if (stager) { R7_TRANSFORM(0) R7_LOAD(1) }
    __syncthreads();
#pragma unroll 1
    for (int c = 0; c < NC; ++c) {
        if (stager) { if (c + 1 < NC) R7_STORE_RAW() if (c > 0) R7_FLUSH(c - 1) }
        else R7_REC(c & 1, 0, c)
        __syncthreads();
        if (stager) { if (c + 1 < NC) R7_TRANSFORM((c + 1) & 1) if (c + 2 < NC) R7_LOAD(c + 2) }
        else R7_REC(c & 1, 16, c)
        __syncthreads();
    }
    if (stager) R7_FLUSH(NC - 1) else __builtin_amdgcn_s_setprio(0);
#undef R7_LOAD
#undef R7_STORE_RAW
#undef R7_TRANSFORM
#undef R7_FLUSH
#undef R7_REC
    __syncthreads();
}

__device__ __forceinline__ void ph_odd_post(const Params& P, int j, int tid) {
    const int lane = tid & 63, gw = blockIdx.x * 8 + (tid >> 6), NGW = gridDim.x * 8;
    const bf16_t* Z = (const bf16_t*)(PWS() + OFF_Z); const bf16_t* HB = (const bf16_t*)((unsigned char*)tabptr(41)); const bf16_t* EXT = (const bf16_t*)(PWS() + OFF_EXT); bf16_t* MIX = (bf16_t*)((unsigned char*)tabptr(42));
    const int c0 = lane * 8;
    float nw[8], lnw[8], lnb[8], mur[8], muk[8], muv[8], kaw[8], rk[8], a0v[8];
#define LD8(dst, ptr) { const f32x4 x0_ = *(const f32x4*)(ptr), x1_ = *(const f32x4*)((ptr) + 4); dst[0] = x0_[0]; dst[1] = x0_[1]; dst[2] = x0_[2]; dst[3] = x0_[3]; dst[4] = x1_[0]; dst[5] = x1_[1]; dst[6] = x1_[2]; dst[7] = x1_[3]; }
    LD8(nw, PIN(21) + j * 512 + c0) LD8(lnw, PIN(31) + j * 512 + c0) LD8(lnb, PIN(32) + j * 512 + c0)
    LD8(mur, PIN(22) + (size_t)j * 1792 + c0) LD8(muk, PIN(22) + (size_t)j * 1792 + 512 + c0) LD8(muv, PIN(22) + (size_t)j * 1792 + 1024 + c0)
    LD8(kaw, PIN(29) + j * 512 + c0) LD8(rk, PIN(30) + j * 512 + c0) LD8(a0v, PIN(25) + j * 512 + c0)
#undef LD8
#define OP_LOAD(W, t_) { const size_t zr_ = (size_t)(t_) * ODN; const bf16_t* mp_ = MIX + (size_t)(t_) * 1024; \
        W[0] = *(const u32x4*)(mp_ + c0); W[1] = *(const u32x4*)(Z + zr_ + 1536 + c0); W[2] = *(const u32x4*)(EXT + (size_t)(t_) * 512 + c0); \
        W[3] = *(const u32x4*)(Z + zr_ + 2048 + c0); W[4] = *(const u32x4*)(Z + zr_ + 2560 + c0); W[5] = *(const u32x4*)(Z + zr_ + 3072 + c0); \
        W[6] = *(const u32x4*)(HB + (size_t)(t_) * 1024 + 512 + c0); W[7] = *(const u32x4*)(mp_ + 512 + c0); }
    const int per = (T + NGW - 1) / NGW, tb = gw * per, te = (tb + per < T) ? (tb + per) : T;
    if (tb < te) {
        const u32x4 z4 = zero_u4();
        u32x4 Pr = z4, Pk = z4, Pv = z4, C[8], N[8];
        if ((tb & (SEQ - 1)) != 0) { const size_t zp = (size_t)(tb - 1) * ODN; Pr = *(const u32x4*)(Z + zp + 2048 + c0); Pk = *(const u32x4*)(Z + zp + 2560 + c0); Pv = *(const u32x4*)(Z + zp + 3072 + c0); }
        OP_LOAD(C, tb)
#pragma unroll 1
        for (int t = tb; t < te; ++t) {
            if (t + 1 < te) OP_LOAD(N, t + 1) else {
#pragma unroll
                for (int q = 0; q < 8; ++q) N[q] = z4; }
            bf16_t* mp = MIX + (size_t)t * 1024;
            if ((t & (SEQ - 1)) == 0) { Pr = z4; Pk = z4; Pv = z4; }
            { float o[8], g[8]; unpack8(C[0], o); unpack8(C[1], g);
              float ss = 0.f;
#pragma unroll
              for (int q = 0; q < 8; ++q) ss += o[q] * o[q];
              ss = wave_sum(ss); const float rs = rsqrtf(ss * (1.0f / 512.0f) + 1e-6f);
#pragma unroll
              for (int q = 0; q < 8; ++q) o[q] = o[q] * rs * nw[q] * sigmoidf_(g[q]);
              *(u32x4*)(mp + c0) = pack8(o); }
            { float y[8], rc[8], kc[8], vc[8], rp[8], kp[8], vp[8], av[8], gt[8];
              unpack8(C[2], y); unpack8(C[3], rc); unpack8(C[4], kc); unpack8(C[5], vc); unpack8(Pr, rp); unpack8(Pk, kp); unpack8(Pv, vp); unpack8(C[6], av); unpack8(C[7], gt);
              float sy = 0.f, dot = 0.f;
#pragma unroll
              for (int q = 0; q < 8; ++q) { av[q] = sigmoidf_(av[q] + a0v[q]); sy += y[q]; const float r = rc[q] + mur[q] * (rp[q] - rc[q]); const float k = kc[q] + muk[q] * (kp[q] - kc[q]); vc[q] = vc[q] + muv[q] * (vp[q] - vc[q]);
                  dot += r * (k * (1.0f + (av[q] - 1.0f) * kaw[q])) * rk[q]; }
              sy = rowsum8(sy); dot = rowsum8(dot); const float mean = sy * (1.0f / 64.0f);
              float sv2 = 0.f;
#pragma unroll
              for (int q = 0; q < 8; ++q) { y[q] -= mean; sv2 += y[q] * y[q]; }
              sv2 = rowsum8(sv2); const float rstd = rsqrtf(sv2 * (1.0f / 64.0f) + 64e-5f);
              float o[8];
#pragma unroll
              for (int q = 0; q < 8; ++q) o[q] = (y[q] * rstd * lnw[q] + lnb[q] + dot * vc[q]) * gt[q];
              *(u32x4*)(mp + 512 + c0) = pack8(o); }
            Pr = C[3]; Pk = C[4]; Pv = C[5];
#pragma unroll
            for (int q = 0; q < 8; ++q) C[q] = N[q];
        }
    }
#undef OP_LOAD
}

__device__ __forceinline__ int ltid() { int t = threadIdx.x; asm volatile("" : "+v"(t)); return t; }
__device__ __forceinline__ void grid_bar() {
    XcdBarrier b; b.bar = (unsigned*)(PWS() + OFF_BAR); b.x = xb_xcc_id(); b.st = (volatile LAS unsigned*)((LAS unsigned char*)smem_g + TAB_OFF + 448);
    xcd_barrier(b);
}
template <class Epi>
__device__ __forceinline__ void run_gemm(LAS unsigned char* lds, const bf16_t* A, const bf16_t* Bt, int N, int K, const Epi& E) {
    pg8::Gemm g; g.A = A; g.Bt = Bt; g.M = T; g.N = N; g.K = K;
    pg8::StaticOrder so; so.init(T, N, (int)gridDim.x, (int)blockIdx.x);
    pg8::gemm_phase<Epi, pg8::StaticOrder, false>(lds, g, so, E, nullptr);
}
template <class Epi>
__device__ __forceinline__ void run_gemm_rs(LAS unsigned char* lds, const bf16_t* A, const bf16_t* Bt, int N, int K, const Epi& E, const float* ss) {
    pg8::StaticOrder so; so.init(T, N, (int)gridDim.x, (int)blockIdx.x);
    { const int tid = ltid(); LAS float* rst = (LAS float*)(lds + RS_OFF); Unit u;
      for (int i = tid >> 8; so.next(i, u); i += 2) { const int r = tid & 255; rst[i * 256 + r] = rsqrtf(rowss(ss, u.pm * 256 + r) * (1.0f / 1024.0f) + 1e-6f); }
      __syncthreads(); }
    pg8::Gemm g; g.A = A; g.Bt = Bt; g.M = T; g.N = N; g.K = K;
    pg8::gemm_phase<Epi, pg8::StaticOrder, false>(lds, g, so, E, nullptr);
}

__global__ void __launch_bounds__(512, 2) trunk_fwd(Params P) {
    LAS unsigned char* lds = (LAS unsigned char*)smem_g;
    if (threadIdx.x == 0) { LAS unsigned long long* t = (LAS unsigned long long*)(lds + TAB_OFF);
        t[0] = (unsigned long long)(uintptr_t)P.in[0];
        t[1] = (unsigned long long)(uintptr_t)P.in[1];
        t[2] = (unsigned long long)(uintptr_t)P.in[2];
        t[3] = (unsigned long long)(uintptr_t)P.in[3];
        t[4] = (unsigned long long)(uintptr_t)P.in[4];
        t[5] = (unsigned long long)(uintptr_t)P.in[5];
        t[6] = (unsigned long long)(uintptr_t)P.in[6];
        t[7] = (unsigned long long)(uintptr_t)P.in[7];
        t[8] = (unsigned long long)(uintptr_t)P.in[8];
        t[9] = (unsigned long long)(uintptr_t)P.in[9];
        t[10] = (unsigned long long)(uintptr_t)P.in[10];
        t[11] = (unsigned long long)(uintptr_t)P.in[11];
        t[12] = (unsigned long long)(uintptr_t)P.in[12];
        t[13] = (unsigned long long)(uintptr_t)P.in[13];
        t[14] = (unsigned long long)(uintptr_t)P.in[14];
        t[15] = (unsigned long long)(uintptr_t)P.in[15];
        t[16] = (unsigned long long)(uintptr_t)P.in[16];
        t[17] = (unsigned long long)(uintptr_t)P.in[17];
        t[18] = (unsigned long long)(uintptr_t)P.in[18];
        t[19] = (unsigned long long)(uintptr_t)P.in[19];
        t[20] = (unsigned long long)(uintptr_t)P.in[20];
        t[21] = (unsigned long long)(uintptr_t)P.in[21];
        t[22] = (unsigned long long)(uintptr_t)P.in[22];
        t[23] = (unsigned long long)(uintptr_t)P.in[23];
        t[24] = (unsigned long long)(uintptr_t)P.in[24];
        t[25] = (unsigned long long)(uintptr_t)P.in[25];
        t[26] = (unsigned long long)(uintptr_t)P.in[26];
        t[27] = (unsigned long long)(uintptr_t)P.in[27];
        t[28] = (unsigned long long)(uintptr_t)P.in[28];
        t[29] = (unsigned long long)(uintptr_t)P.in[29];
        t[30] = (unsigned long long)(uintptr_t)P.in[30];
        t[31] = (unsigned long long)(uintptr_t)P.in[31];
        t[32] = (unsigned long long)(uintptr_t)P.in[32];
        t[33] = (unsigned long long)(uintptr_t)P.in[33];
        t[34] = (unsigned long long)(uintptr_t)P.in[34];
        t[35] = (unsigned long long)(uintptr_t)P.in[35];
        t[36] = (unsigned long long)(uintptr_t)P.in[36];
        t[37] = (unsigned long long)(uintptr_t)P.in[37];
        t[38] = (unsigned long long)(uintptr_t)P.in[38];
        t[39] = (unsigned long long)(uintptr_t)P.ws; t[40] = (unsigned long long)(uintptr_t)P.out;
        volatile LAS unsigned* st = (volatile LAS unsigned*)(lds + TAB_OFF + 448); st[0] = 0u; st[1] = 0u; }
    __syncthreads();
    (void)xcd_barrier_post((unsigned*)(P.ws + OFF_BAR), (volatile LAS unsigned*)(lds + TAB_OFF + 448));
    cg::grid_group grid = cg::this_grid();
#define ws PWS()
#define Zb ((bf16_t*)(ws + OFF_Z))
#define HB ((bf16_t*)tabptr(43))
#define HOTH ((bf16_t*)tabptr(44))
#define MIX ((bf16_t*)tabptr(42))
#define ACT ((bf16_t*)(ws + OFF_ACT))
#define UP ((bf16_t*)(ws + OFF_UP))
#define PB ((bf16_t*)(ws + OFF_PB))
#define LAo ((bf16_t*)(ws + OFF_LA))
#define ssA ((float*)(ws + OFF_SS))
#define ssB ((float*)(ws + OFF_SS) + 16 * T)
#define ssC ((float*)(ws + OFF_SS) + 32 * T)

    ph_convert(P, 0, lds, ltid());
    ph_prologue(P, ltid());
    grid.sync();

#pragma unroll 1
    for (int L = 0; L < 4; ++L) {
        const int j = L >> 1; const bool odd = (L & 1) != 0;
#define j lsg(L >> 1)
#define Wb ((const bf16_t*)(ws + OFF_W) + (odd ? WO_BASE : 0))
#define hin HB
        if (threadIdx.x == 0) { LAS unsigned long long* t = (LAS unsigned long long*)(lds + TAB_OFF);
            const unsigned long long h0 = (unsigned long long)(uintptr_t)(PWS() + OFF_HB), h1 = (unsigned long long)(uintptr_t)POUT(), mx = h1 + (unsigned long long)T * 1024 * 2;
            t[43] = odd ? h1 : h0; t[44] = odd ? h0 : h1; t[41] = odd ? h0 : h1; t[42] = mx; }
        __syncthreads();
        if (!odd) { EpiZ e; e.Z = Zb; e.ldc = EVN; e.ss = ssA; run_gemm_rs(lds, hin, Wb + WE_IN, EVN, 1024, e, ssA); }
        else      { EpiZ e; e.Z = Zb; e.ldc = ODN; e.ss = ssA; run_gemm_rs(lds, hin, Wb + WO_IN, ODN, 1024, e, ssA); }
        grid_bar();
#ifndef NO_EVEN
        if (!odd) {
            if (L + 1 < 4) ph_convert(P, L + 1, lds, ltid());
            ph_convert_p(P, L, ltid());
            __syncthreads();
            ph_rg_prep(P, j, lds, ltid());
            ph_gdn_prep(P, j, ltid());
            grid_bar();
            for (int task = blockIdx.x; task < 512; task += gridDim.x) { if (task < 256) ph_gdn(P, j, task, lds, ltid()); else ph_rg_scan(P, task - 256, lds, ltid()); }
            grid_bar();
            ph_gdn_post(P, j, ltid());
            grid_bar();
        }
#endif
#ifndef NO_ODD
        if (odd) {
            if (L + 1 < 4) ph_convert(P, L + 1, lds, ltid());
            ph_convert_p(P, L, ltid());
            ph_lora_prep(P, j, ltid());
            grid_bar();
            { EpiLora e; e.HBp = HOTH; e.MIXp = MIX; run_gemm(lds, LAo, Wb + WO_LORA, 1536, 256, e); }
            grid_bar();
            for (int task = blockIdx.x; task < 256; task += gridDim.x) { if (task < 128) ph_hgrn(P, j, task, lds, ltid()); else ph_rwkv(P, j, task - 128, lds, ltid()); }
            grid_bar();
            ph_odd_post(P, j, ltid());
            grid_bar();
        }
#endif
        { EpiRes e; e.Hp = HB; e.ssn = ssB; run_gemm(lds, MIX, Wb + (odd ? WO_OUT : WE_OUT), 1024, 1024, e); }
        grid_bar();
        { EpiGU e; e.ACTp = ACT; e.ss = ssB; run_gemm_rs(lds, HB, Wb + (odd ? WO_GU : WE_GU), 5632, 1024, e, ssB); }
        { EpiUp e; e.O = UP; run_gemm(lds, PB, Wb + (odd ? WO_PU : WE_PU), 1024, 256, e); }
        grid_bar();
        { EpiRes e; e.Hp = HB; e.ssn = ssC; run_gemm(lds, ACT, Wb + (odd ? WO_DN : WE_DN), 1024, 2816, e); }
        grid_bar();
        { EpiPle e; e.Hin = HB; e.Hout = HOTH; e.ssn = ssA; e.ss = ssC; e.UPp = UP; run_gemm_rs(lds, HB, Wb + (odd ? WO_PG : WE_PG), 1024, 1024, e, ssC); }
        grid_bar();
    }
#undef j
#undef Wb
#undef hin
    ph_final(P, ltid());
}

#undef ws
#undef Zb
#undef HB
#undef HOTH
#undef MIX
#undef ACT
#undef UP
#undef PB
#undef LAo
#undef ssA
#undef ssB
#undef ssC
extern "C" void kernel_launch(void* const* d_in, const int* in_sizes, int n_in, void* d_out, int out_size, void* d_ws, size_t ws_size, hipStream_t stream) {
    static int grid_blocks = 0;
    if (grid_blocks == 0) {
        if (n_in != 39 || out_size != T * DM || ws_size < WS_END) { fprintf(stderr, "kernel_launch: unexpected shapes: n_in %d out %d ws %zu (need %zu)\n", n_in, out_size, ws_size, (size_t)WS_END); grid_blocks = -1; return; }
        int dev = 0, cus = 0, per_cu = 0;
        hipGetDevice(&dev);
        hipDeviceGetAttribute(&cus, hipDeviceAttributeMultiprocessorCount, dev);
        if (hipFuncSetAttribute((const void*)trunk_fwd, hipFuncAttributeMaxDynamicSharedMemorySize, LDS_BYTES) != hipSuccess) { fprintf(stderr, "kernel_launch: hipFuncSetAttribute failed\n"); grid_blocks = -1; return; }
        if (hipOccupancyMaxActiveBlocksPerMultiprocessor(&per_cu, (const void*)trunk_fwd, 512, LDS_BYTES) != hipSuccess || per_cu < 1) { fprintf(stderr, "kernel_launch: occupancy query says %d\n", per_cu); per_cu = 1; }
        (void)hipGetLastError();
        grid_blocks = cus;
        fprintf(stderr, "kernel_launch: grid %d (per_cu %d), ws %zu need %zu\n", grid_blocks, per_cu, ws_size, (size_t)WS_END);
    }
    if (grid_blocks < 0) return;
    Params p{};
    for (int i = 0; i < 39; ++i) p.in[i] = (const float*)d_in[i];
    p.out = (float*)d_out; p.ws = (unsigned char*)d_ws;
    if (hipMemsetAsync((unsigned char*)d_ws + OFF_BAR, 0, 16384, stream) != hipSuccess) { fprintf(stderr, "kernel_launch: memset of the barrier words failed\n"); return; }
    void* args[] = {&p};
    hipError_t e = hipLaunchCooperativeKernel((const void*)trunk_fwd, dim3(grid_blocks), dim3(512), args, LDS_BYTES, stream);
    if (e != hipSuccess) fprintf(stderr, "cooperative launch failed: %s (grid %d)\n", hipGetErrorString(e), grid_blocks);
}
```
